# Optimizing an MI355X kernel written in HIP

```python
import math
import jax, jax.numpy as jnp
from jax import lax
import numpy as np

D_MODEL = 1024
BATCH = 1
SEQ = 16384
DEPTH = 4

CHUNK = 64
D_MIX = D_MODEL
D_LRU = D_MIX // 2
LRU_BLOCKS = 8
LRU_BLOCK = D_LRU // LRU_BLOCKS
CONV_WIDTH = 4
LRU_C = 8.0
GLA_HEADS = 4
GLA_DV = (D_MIX - D_LRU) // GLA_HEADS
GLA_DK = GLA_DV // 2
GLA_K = GLA_HEADS * GLA_DK
GLA_V = GLA_HEADS * GLA_DV
GATE_RANK = 16
GATE_TAU = 16.0
D_FF = ((8 * D_MODEL // 3 + 255) // 256) * 256
EPS = 1e-6

SPLIT_SIZES = (D_LRU, D_LRU, GLA_K, GLA_K, GLA_V, GLA_V, GATE_RANK)
P_IN = sum(SPLIT_SIZES)
SPLIT_IDX = tuple(int(v) for v in np.cumsum(SPLIT_SIZES)[:-1])

kernel_name = "hymba_style_rglru_gla_hybrid"


def rms_norm(x, gain):
    xf = x.astype(jnp.float32)
    y = xf * lax.rsqrt(jnp.mean(xf * xf, axis=-1, keepdims=True) + EPS)
    return (y * gain.astype(jnp.float32)).astype(x.dtype)


def causal_depthwise_conv(x, w, b):
    seq = x.shape[1]
    xp = jnp.pad(x, ((0, 0), (CONV_WIDTH - 1, 0), (0, 0)))
    y = xp[:, 0:seq, :] * w[0]
    for j in range(1, CONV_WIDTH):
        y = y + xp[:, j:j + seq, :] * w[j]
    return y + b


def block_diag_linear(x, w, b):
    xb = x.reshape(x.shape[:-1] + (LRU_BLOCKS, LRU_BLOCK))
    y = jnp.einsum("bsni,nij->bsnj", xb, w.astype(x.dtype))
    return y.reshape(x.shape) + b.astype(x.dtype)


def rg_lru(x, w_a, b_a, w_i, b_i, lam):
    xf = x.astype(jnp.float32)
    r = jax.nn.sigmoid(block_diag_linear(xf, w_a, b_a))
    i = jax.nn.sigmoid(block_diag_linear(xf, w_i, b_i))
    log_a = -LRU_C * r * jax.nn.softplus(-lam.astype(jnp.float32))
    a = jnp.exp(log_a)
    u = jnp.sqrt(-jnp.expm1(2.0 * log_a)) * (i * xf)

    def step(h, au):
        a_t, u_t = au
        h = a_t * h + u_t
        return h, h

    h0 = jnp.zeros((xf.shape[0], xf.shape[2]), jnp.float32)
    _, hs = lax.scan(step, h0, (a.swapaxes(0, 1), u.swapaxes(0, 1)))
    return hs.swapaxes(0, 1).astype(x.dtype)


def gla_chunk_causal(q, k, v, log_alpha):
    bsz, seq = q.shape[:2]
    nc = seq // CHUNK

    def rs(t):
        return t.astype(jnp.float32).reshape(bsz, nc, CHUNK, GLA_HEADS, t.shape[-1])

    q, k, v, la = rs(q), rs(k), rs(v), rs(log_alpha)
    bcum = jnp.cumsum(la, axis=2)
    b_end = bcum[:, :, -1:]
    k_dec = k * jnp.exp(b_end - bcum)
    q_dec = q * jnp.exp(b_end)
    scores = jnp.einsum("bnshd,bnthd->bnhst", q, k_dec)
    o_intra = jnp.einsum("bnhst,bnthv->bnshv", scores, v)
    updates = jnp.einsum("bnthd,bnthv->bnhdv", k_dec, v)
    decay = jnp.exp(b_end[:, :, 0])

    def step(state, inp):
        d, upd = inp
        return d[..., None] * state + upd, state

    s0 = jnp.zeros((bsz, GLA_HEADS, GLA_DK, GLA_DV), jnp.float32)
    _, s_prev = lax.scan(step, s0, (decay.swapaxes(0, 1), updates.swapaxes(0, 1)))
    s_prev = s_prev.swapaxes(0, 1)
    o_inter = jnp.einsum("bnshd,bnhdv->bnshv", q_dec, s_prev)
    return (o_intra + o_inter).reshape(bsz, seq, GLA_HEADS, GLA_DV)


def setup_inputs(seed: int = 0) -> dict:
    key = jax.random.key(seed)
    ks = jax.random.split(key, 24)
    f32 = jnp.float32

    def nrm(k, shape, scale):
        return jax.random.normal(k, shape, f32) * scale

    def gain(k, shape):
        return 1.0 + 0.02 * jax.random.normal(k, shape, f32)

    u = jax.random.uniform(ks[10], (DEPTH, D_LRU), f32, 0.9, 0.999)
    s = u ** (1.0 / LRU_C)
    lam = jnp.log(s) - jnp.log1p(-s)
    return {
        "x": jax.random.normal(ks[0], (BATCH, SEQ, D_MODEL), f32),
        "norm1": gain(ks[1], (DEPTH, D_MODEL)),
        "w_in": nrm(ks[2], (DEPTH, D_MODEL, P_IN), D_MODEL ** -0.5),
        "conv_w": nrm(ks[3], (DEPTH, CONV_WIDTH, D_LRU), CONV_WIDTH ** -0.5),
        "conv_b": nrm(ks[4], (DEPTH, D_LRU), 0.02),
        "lru_wa": nrm(ks[5], (DEPTH, LRU_BLOCKS, LRU_BLOCK, LRU_BLOCK), LRU_BLOCK ** -0.5),
        "lru_ba": nrm(ks[6], (DEPTH, D_LRU), 0.02),
        "lru_wi": nrm(ks[7], (DEPTH, LRU_BLOCKS, LRU_BLOCK, LRU_BLOCK), LRU_BLOCK ** -0.5),
        "lru_bi": nrm(ks[8], (DEPTH, D_LRU), 0.02),
        "lru_lambda": lam,
        "gla_w_alpha": nrm(ks[11], (DEPTH, GATE_RANK, GLA_K), GATE_RANK ** -0.5),
        "gla_b_alpha": nrm(ks[12], (DEPTH, GLA_K), 0.02),
        "gla_norm": gain(ks[13], (DEPTH, GLA_DV)),
        "w_out": nrm(ks[14], (DEPTH, D_MIX, D_MODEL), D_MIX ** -0.5),
        "norm2": gain(ks[15], (DEPTH, D_MODEL)),
        "w_ffn_in": nrm(ks[16], (DEPTH, D_MODEL, 2 * D_FF), D_MODEL ** -0.5),
        "w_ffn_out": nrm(ks[17], (DEPTH, D_FF, D_MODEL), D_FF ** -0.5),
        "final_norm": gain(ks[18], (D_MODEL,)),
    }


def reference(x, norm1, w_in, conv_w, conv_b, lru_wa, lru_ba, lru_wi, lru_bi,
              lru_lambda, gla_w_alpha, gla_b_alpha, gla_norm, w_out, norm2,
              w_ffn_in, w_ffn_out, final_norm):
    bsz, seq, _ = x.shape
    q_scale = GLA_DK ** -0.5
    for l in range(DEPTH):
        h = rms_norm(x, norm1[l])
        p = h @ w_in[l]
        lru_x, lru_g, q, k, v, g, z = jnp.split(p, SPLIT_IDX, axis=-1)

        lru_x = causal_depthwise_conv(lru_x, conv_w[l], conv_b[l])
        lru_o = rg_lru(lru_x, lru_wa[l], lru_ba[l], lru_wi[l], lru_bi[l],
                       lru_lambda[l]) * jax.nn.gelu(lru_g)

        zf = z.astype(jnp.float32) @ gla_w_alpha[l].astype(jnp.float32) + gla_b_alpha[l]
        log_alpha = jax.nn.log_sigmoid(zf) / GATE_TAU
        qh = (q * q_scale).reshape(bsz, seq, GLA_HEADS, GLA_DK)
        kh = k.reshape(bsz, seq, GLA_HEADS, GLA_DK)
        vh = v.reshape(bsz, seq, GLA_HEADS, GLA_DV)
        lah = log_alpha.reshape(bsz, seq, GLA_HEADS, GLA_DK)
        o = gla_chunk_causal(qh, kh, vh, lah)
        o = rms_norm(o, gla_norm[l]).reshape(bsz, seq, GLA_V).astype(x.dtype)
        gla_o = o * jax.nn.silu(g)

        mix = jnp.concatenate([lru_o, gla_o], axis=-1) @ w_out[l]
        x = x + mix

        h = rms_norm(x, norm2[l])
        gate, up = jnp.split(h @ w_ffn_in[l], 2, axis=-1)
        x = x + (jax.nn.silu(gate) * up) @ w_ffn_out[l]
    return rms_norm(x, final_norm)
```

```cpp
#include <hip/hip_runtime.h>
#include <hip/hip_cooperative_groups.h>
#include <cstdio>
namespace cg = cooperative_groups;
#ifndef SINGLE_LAUNCH
#define SINGLE_LAUNCH 1
#endif
__device__ __forceinline__ int opaque_tid() { int t = threadIdx.x; asm volatile("" : "+v"(t)); return t; }
namespace pg8 {
#define PG8_LAS __attribute__((address_space(3)))
typedef unsigned short bf16_t;
typedef short bf16x8 __attribute__((ext_vector_type(8)));
typedef float f32x4 __attribute__((ext_vector_type(4)));
typedef unsigned u32x4 __attribute__((ext_vector_type(4)));
constexpr int BM = 256, BK = 64, HALF = 128, HTB = HALF * BK * 2  , STAGE_BYTES = 8 * HTB, NXCD = 8, WGM = 8;

__host__ __device__ __forceinline__ int lds_byte(int r, int c) { const int st = (r >> 4) * 2 + (c >> 5), rr = r & 15, cc = c & 31, ob = rr * 64 + cc * 2; return st * 1024 + (ob ^ (((ob >> 9) & 1) << 5)); }
__host__ __device__ __forceinline__ void stage_rc(int b, int& R, int& C) { const int st = b / 1024, sb = b % 1024, swz = sb ^ (((sb >> 9) & 1) << 5); R = (st >> 1) * 16 + swz / 64; C = (st & 1) * 32 + (swz % 64) / 2; }
__host__ __device__ __forceinline__ int perm32(int rho) { const int n = rho >> 4, i = rho & 15; return 8 * (i >> 2) + 4 * n + (i & 3); }

struct Unit { int pm, pn, ui; };
struct Gemm { const bf16_t* A; const bf16_t* Bt; int M, N, K; };

struct StaticOrder {
    int nM, nN, nwg, G, c;
    __host__ __device__ void init(int M, int N, int G_, int c_) { nM = M / BM; nN = N / BM; nwg = nM * nN; G = G_; c = c_; }
    __host__ __device__ bool next(int i, Unit& u) const {
        const long L = (long)i * G + c; if (L >= nwg) return false;
        int wgid = (int)L; { const int q = nwg / NXCD, r = nwg % NXCD, xcd = wgid % NXCD, off = wgid / NXCD; wgid = (xcd < r ? xcd * (q + 1) : r * (q + 1) + (xcd - r) * q) + off; }
        const int nig = WGM * nN, gid = wgid / nig, fm = gid * WGM, gsz = (nM - fm) < WGM ? (nM - fm) : WGM;
        u.pm = fm + ((wgid % nig) % gsz); u.pn = (wgid % nig) / gsz; u.ui = i; return true;
    }
    __device__ __forceinline__ void a_ready(const Unit&) const {}
    __device__ __forceinline__ void done(const Unit&) const {}
};
__device__ __forceinline__ unsigned cvt_pk_bf16(float lo, float hi) { unsigned r; asm volatile("v_cvt_pk_bf16_f32 %0, %1, %2" : "=v"(r) : "v"(lo), "v"(hi)); return r; }
template <class Epi, class Sched, bool ALIGN_EPI = false, bool SP2 = false>
__device__ __forceinline__ void gemm_phase(PG8_LAS unsigned char* lds, const Gemm g, const Sched& S, const Epi& E) {
    const int tid = opaque_tid(), wid = __builtin_amdgcn_readfirstlane(tid >> 6), lane = tid & 63, wr = wid >> 2, wc = wid & 3, fr = lane & 15, fq = lane >> 4;
    const int K = g.K, nt = K / BK;
    unsigned voffA[2], voffB[2];
#pragma unroll
    for (int i = 0; i < 2; ++i) { int R, C; stage_rc(tid * 16 + i * 8192, R, C); const int Rb = Epi::PERM ? ((R & ~31) + perm32(R & 31)) : R;
        voffA[i] = (unsigned)(R * K + C) * 2u; voffB[i] = (unsigned)(Rb * K + C) * 2u; }
    const size_t kstep = (size_t)(BK * 2);
    const size_t hstep = (size_t)HALF * K * 2;
    const size_t tstep = 2 * hstep;
    const unsigned ldsw = (unsigned)wid * 1024u;
    const int aoff = lds_byte(wr * 64 + fr, fq * 8), boff = lds_byte(wc * 32 + fr, fq * 8);
#define PG8_SA(b, h) (((b) * 2 + (h)) * HTB)
#define PG8_SB(b, h) ((4 + (b) * 2 + (h)) * HTB)
#define PG8_STAGE(bufoff, gbase, voff) do { _Pragma("unroll") for (int _i = 0; _i < 2; ++_i) \
        __builtin_amdgcn_global_load_lds((const unsigned*)((const char*)(gbase) + (voff)[_i]), (PG8_LAS unsigned*)(lds + (bufoff) + ldsw + _i * 8192), 16, 0, 0); } while (0)
#define PG8_LDA(dst, b, h) do { _Pragma("unroll") for (int m = 0; m < 4; ++m) _Pragma("unroll") for (int k = 0; k < 2; ++k) dst[m][k] = *(const PG8_LAS bf16x8*)(lds + PG8_SA(b, h) + aoff + m * 2048 + k * 1024); } while (0)
#define PG8_LDB(dst, b, h) do { _Pragma("unroll") for (int n = 0; n < 2; ++n) _Pragma("unroll") for (int k = 0; k < 2; ++k) dst[n][k] = *(const PG8_LAS bf16x8*)(lds + PG8_SB(b, h) + boff + n * 2048 + k * 1024); } while (0)
#define PG8_MMA(ai, bj, At, Bt) do { __builtin_amdgcn_s_setprio(1); _Pragma("unroll") for (int m = 0; m < 4; ++m) _Pragma("unroll") for (int n = 0; n < 2; ++n) _Pragma("unroll") for (int k = 0; k < 2; ++k) \
        acc[ai][bj][m][n] = __builtin_amdgcn_mfma_f32_16x16x32_bf16(Bt[n][k], At[m][k], acc[ai][bj][m][n], 0, 0, 0); __builtin_amdgcn_s_setprio(0); } while (0)
#define PG8_WAIT_V(n) asm volatile("s_waitcnt vmcnt(" #n ")" ::: "memory")
#define PG8_WAIT_L(n) asm volatile("s_waitcnt lgkmcnt(" #n ")" ::: "memory")
#define PG8_BAR __builtin_amdgcn_s_barrier()
#define PG8_SCHED __builtin_amdgcn_sched_barrier(0)
    Unit cur, nxt; int ui = 0;
    if (!S.next(0, cur)) return;
    f32x4 acc[2][2][4][2];
    u32x4 raw_init[2][4][2];
    if constexpr (Epi::INIT_ACC) E.load_init(raw_init, cur, wr, wc, fr, fq);
    else {
#pragma unroll
    for (int a = 0; a < 2; ++a)
#pragma unroll
        for (int b = 0; b < 2; ++b)
#pragma unroll
            for (int m = 0; m < 4; ++m)
#pragma unroll
                for (int n = 0; n < 2; ++n) acc[a][b][m][n] = (f32x4){0.f, 0.f, 0.f, 0.f};
    }
    bf16x8 At[4][2], B0[2][2], B1[2][2];
    const char* cA = (const char*)g.A + (size_t)cur.pm * tstep; const char* cB = (const char*)g.Bt + (size_t)cur.pn * tstep;
    S.a_ready(cur);
    if constexpr (SP2) {
        PG8_STAGE(PG8_SB(0, 0), cB, voffB); PG8_STAGE(PG8_SB(0, 1), cB + hstep, voffB); PG8_STAGE(PG8_SA(0, 0), cA, voffA); PG8_STAGE(PG8_SA(0, 1), cA + hstep, voffA);
        if (wr == 1) PG8_BAR;
        PG8_WAIT_V(2); PG8_BAR;
        PG8_STAGE(PG8_SB(1, 0), cB + kstep, voffB); PG8_STAGE(PG8_SA(1, 0), cA + kstep, voffA); PG8_STAGE(PG8_SB(1, 1), cB + hstep + kstep, voffB);
        if constexpr (Epi::HAS_PRE) E.pre(S);
        PG8_WAIT_V(6); PG8_BAR;
    } else {
        PG8_STAGE(PG8_SB(0, 0), cB, voffB); PG8_STAGE(PG8_SA(0, 0), cA, voffA); PG8_STAGE(PG8_SB(0, 1), cB + hstep, voffB); PG8_STAGE(PG8_SA(0, 1), cA + hstep, voffA);
        if (wr == 1) PG8_BAR;
        PG8_WAIT_V(4); PG8_BAR;
        PG8_STAGE(PG8_SB(1, 0), cB + kstep, voffB); PG8_STAGE(PG8_SA(1, 0), cA + kstep, voffA); PG8_STAGE(PG8_SB(1, 1), cB + hstep + kstep, voffB);
        PG8_WAIT_V(6); PG8_BAR;
    }
    if constexpr (Epi::INIT_ACC) { PG8_SCHED; E.unpack_init(acc, raw_init); PG8_SCHED; }
    for (;;) {
        const bool has_next = S.next(ui + 1, nxt);
        const char* nA = has_next ? (const char*)g.A + (size_t)nxt.pm * tstep : cA; const char* nB = has_next ? (const char*)g.Bt + (size_t)nxt.pn * tstep : cB;
        for (int t = 0; t < nt; t += 2) {
            const bool last = (t == nt - 2);
            const char* a1 = cA + (size_t)(t + 1) * kstep;
            const char* a2 = last ? nA : cA + (size_t)(t + 2) * kstep; const char* b2 = last ? nB : cB + (size_t)(t + 2) * kstep;
            const char* a3 = a2 + kstep; const char* b3 = b2 + kstep;
            if (last && has_next) S.a_ready(nxt);
            if constexpr (SP2) {
            PG8_LDB(B0, 0, 0); PG8_LDB(B1, 0, 1); PG8_SCHED; PG8_LDA(At, 0, 0); PG8_STAGE(PG8_SA(1, 1), a1 + hstep, voffA);
            PG8_WAIT_V(8); PG8_WAIT_L(0); PG8_BAR; PG8_MMA(0, 0, At, B0); PG8_MMA(0, 1, At, B1); PG8_BAR; PG8_SCHED;
            PG8_LDA(At, 0, 1); PG8_STAGE(PG8_SB(0, 0), b2, voffB); PG8_STAGE(PG8_SB(0, 1), b2 + hstep, voffB); PG8_STAGE(PG8_SA(0, 0), a2, voffA);
            PG8_WAIT_V(8); PG8_WAIT_L(0); PG8_BAR; PG8_MMA(1, 0, At, B0); PG8_MMA(1, 1, At, B1); PG8_BAR; PG8_SCHED;
            PG8_LDB(B0, 1, 0); PG8_LDB(B1, 1, 1); PG8_SCHED; PG8_LDA(At, 1, 0); PG8_STAGE(PG8_SA(0, 1), a2 + hstep, voffA);
            PG8_WAIT_V(8); PG8_WAIT_L(0); PG8_BAR; PG8_MMA(0, 0, At, B0); PG8_MMA(0, 1, At, B1); PG8_BAR; PG8_SCHED;
            PG8_LDA(At, 1, 1); PG8_STAGE(PG8_SB(1, 0), b3, voffB); PG8_STAGE(PG8_SB(1, 1), b3 + hstep, voffB); PG8_STAGE(PG8_SA(1, 0), a3, voffA);
            PG8_WAIT_V(8); PG8_WAIT_L(0); PG8_BAR; PG8_MMA(1, 0, At, B0); PG8_MMA(1, 1, At, B1); PG8_BAR; PG8_SCHED;
            } else {
            PG8_LDB(B0, 0, 0); PG8_SCHED; PG8_LDA(At, 0, 0); PG8_STAGE(PG8_SA(1, 1), a1 + hstep, voffA);
            PG8_WAIT_L(8); PG8_BAR; PG8_WAIT_L(0); PG8_MMA(0, 0, At, B0); PG8_BAR; PG8_SCHED;
            PG8_LDB(B1, 0, 1); PG8_STAGE(PG8_SB(0, 0), b2, voffB);
            PG8_BAR; PG8_WAIT_L(0); PG8_MMA(0, 1, At, B1); PG8_BAR;
            PG8_LDA(At, 0, 1); PG8_STAGE(PG8_SA(0, 0), a2, voffA);
            PG8_BAR; PG8_WAIT_L(0); PG8_MMA(1, 0, At, B0); PG8_BAR; PG8_SCHED;
            PG8_STAGE(PG8_SB(0, 1), b2 + hstep, voffB);
            PG8_WAIT_V(6); PG8_BAR; PG8_MMA(1, 1, At, B1); PG8_BAR;
            PG8_LDB(B0, 1, 0); PG8_SCHED; PG8_LDA(At, 1, 0); PG8_STAGE(PG8_SA(0, 1), a2 + hstep, voffA);
            PG8_WAIT_L(8); PG8_BAR; PG8_WAIT_L(0); PG8_MMA(0, 0, At, B0); PG8_BAR; PG8_SCHED;
            PG8_LDB(B1, 1, 1); PG8_STAGE(PG8_SB(1, 0), b3, voffB);
            PG8_BAR; PG8_WAIT_L(0); PG8_MMA(0, 1, At, B1); PG8_BAR;
            PG8_LDA(At, 1, 1); PG8_STAGE(PG8_SA(1, 0), a3, voffA);
            PG8_BAR; PG8_WAIT_L(0); PG8_MMA(1, 0, At, B0); PG8_BAR; PG8_SCHED;
            PG8_STAGE(PG8_SB(1, 1), b3 + hstep, voffB);
            PG8_WAIT_V(6); PG8_BAR; PG8_MMA(1, 1, At, B1); PG8_BAR;
            }
        }
        if constexpr (ALIGN_EPI) { if (wr == 0) PG8_BAR; }
        if constexpr (!Epi::AFTER_DRAIN) { E(acc, cur, wr, wc, fr, fq); S.done(cur); }
        if (!has_next) break;
        if constexpr (Epi::INIT_ACC) { E.load_init(raw_init, nxt, wr, wc, fr, fq); E.unpack_init(acc, raw_init); }
        else {
#pragma unroll
        for (int a = 0; a < 2; ++a)
#pragma unroll
            for (int b = 0; b < 2; ++b)
#pragma unroll
                for (int m = 0; m < 4; ++m)
#pragma unroll
                    for (int n = 0; n < 2; ++n) acc[a][b][m][n] = (f32x4){0.f, 0.f, 0.f, 0.f};
        }
        cur = nxt; cA = nA; cB = nB; ++ui;
        if constexpr (ALIGN_EPI) { if (wr == 1) PG8_BAR; }
    }
    PG8_WAIT_V(0);
    if constexpr (!ALIGN_EPI) { if (wr == 0) PG8_BAR; }
    PG8_BAR;
    if constexpr (Epi::AFTER_DRAIN) { E.fused(acc, cur, wr, wc, fr, fq, lds, wid, lane); S.done(cur); }
#undef PG8_SA
#undef PG8_SB
#undef PG8_STAGE
#undef PG8_LDA
#undef PG8_LDB
#undef PG8_MMA
#undef PG8_WAIT_V
#undef PG8_WAIT_L
#undef PG8_BAR
#undef PG8_SCHED
}
}
#define XB_TMO      128
#define XB_XCNT(j)  (256  + 64 * (j))
#define XB_XSUB(j)  (1280 + 64 * (j))
#define XB_XGEN(j)  (2304 + 64 * (j))
#define XB_TOP      3328
#define XB_TOPGEN   3392
#define XCD_BAR_WORDS 3456
#define XB_SPIN_CAP (1u << 18)

__device__ __forceinline__ unsigned xb_ld(unsigned* p)              { return __hip_atomic_load(p, __ATOMIC_RELAXED, __HIP_MEMORY_SCOPE_AGENT); }
__device__ __forceinline__ unsigned xb_add(unsigned* p, unsigned v) { return __hip_atomic_fetch_add(p, v, __ATOMIC_RELAXED, __HIP_MEMORY_SCOPE_AGENT); }
__device__ __forceinline__ unsigned xb_xcc_id() { return (unsigned)__builtin_amdgcn_s_getreg((3 << 11) | 20) & 0xFu; }
#define XB_SPIN(cond, bar) do { unsigned _sp = 0; while (cond) { __builtin_amdgcn_s_sleep(1); \
    if ((++_sp & 255u) == 0u) { if (xb_ld(&(bar)[XB_TMO])) break; if (_sp > XB_SPIN_CAP) { atomicAdd(&(bar)[XB_TMO], 1u); break; } } } } while (0)

struct XcdBarrier {
    unsigned* bar; unsigned x;
    volatile PG8_LAS unsigned* st;
};

__device__ __forceinline__ XcdBarrier xcd_barrier_post(unsigned* bar, volatile PG8_LAS unsigned* st) {
    XcdBarrier b; b.bar = bar; b.x = xb_xcc_id(); b.st = st;
    if (threadIdx.x == 0) (void)xb_add(&bar[XB_XCNT(b.x)], 1u);
    return b;
}
__device__ __forceinline__ void xcd_barrier_complete(unsigned* bar, unsigned x, unsigned& nloc, unsigned& nx) {
    const unsigned G = gridDim.x * gridDim.y * gridDim.z;
    unsigned sum, cnt, mine, sp = 0u;
    for (;;) {
        sum = 0u; cnt = 0u; mine = 0u;
#pragma unroll
        for (unsigned j = 0; j < 16; ++j) { const unsigned c = xb_ld(&bar[XB_XCNT(j)]); sum += c; cnt += (c > 0u) ? 1u : 0u; mine = (j == x) ? c : mine; }
        if (sum == G) break;
        __builtin_amdgcn_s_sleep(1);
        if ((++sp & 255u) == 0u) { if (xb_ld(&bar[XB_TMO])) break; if (sp > XB_SPIN_CAP) { atomicAdd(&bar[XB_TMO], 1u); break; } }
    }
    nloc = mine > 0u ? mine : 1u; nx = cnt > 0u ? cnt : 1u;
}

__device__ __forceinline__ void xcd_barrier(const XcdBarrier& b) {
    asm volatile("s_waitcnt vmcnt(0)" ::: "memory");
    __syncthreads();
    if (threadIdx.x == 0) {
        unsigned* bar = b.bar;
        __builtin_amdgcn_s_waitcnt(0);
        unsigned nloc = b.st[0], nx = b.st[1];
        if (nloc == 0u) { xcd_barrier_complete(bar, b.x, nloc, nx); b.st[0] = nloc; b.st[1] = nx; }
        const unsigned old = xb_add(&bar[XB_XSUB(b.x)], 1u);
        const unsigned gen = old / nloc;
        if (old + 1u == (gen + 1u) * nloc) {
            __builtin_amdgcn_fence(__ATOMIC_RELEASE, "agent");
            asm volatile("s_waitcnt vmcnt(0)" ::: "memory");
            const unsigned og = xb_add(&bar[XB_TOP], 1u);
            const unsigned tg = og / nx;
            if (og + 1u == (tg + 1u) * nx) xb_add(&bar[XB_TOPGEN], 1u);
            else XB_SPIN(xb_ld(&bar[XB_TOPGEN]) == tg, bar);
            __builtin_amdgcn_fence(__ATOMIC_ACQUIRE, "agent");
            xb_add(&bar[XB_XGEN(b.x)], 1u);
            asm volatile("s_waitcnt vmcnt(0)" ::: "memory");
        } else {
            XB_SPIN(xb_ld(&bar[XB_XGEN(b.x)]) == gen, bar);
            __builtin_amdgcn_fence(__ATOMIC_ACQUIRE, "agent");
            asm volatile("s_waitcnt vmcnt(0)" ::: "memory");
        }
    }
    __syncthreads();
}
using pg8::bf16_t; using pg8::bf16x8; using pg8::f32x4; using pg8::u32x4; using pg8::cvt_pk_bf16;
#define LAS PG8_LAS
typedef unsigned u32x2 __attribute__((ext_vector_type(2)));
typedef float f32x2 __attribute__((ext_vector_type(2)));

constexpr int SEQ = 16384, DM = 1024, DEPTH = 4, PIN = 2576, PN = 2816, DFF = 2816, DLRU = 512, NCH = 256, CHUNK = 64;
constexpr int C_LG = 512, C_Q = 1024, C_K = 1280, C_V = 1536, C_G = 2048, C_Z = 2560;
constexpr float EPS = 1e-6f;
constexpr size_t al256(size_t x) { return (x + 255) & ~(size_t)255; }
constexpr size_t WS_WIN = 0;
constexpr size_t WS_WOUT = WS_WIN + al256((size_t)DEPTH * PN * DM * 2);
constexpr size_t WS_WF1 = WS_WOUT + al256((size_t)DEPTH * DM * DM * 2);
constexpr size_t WS_WF2 = WS_WF1 + al256((size_t)DEPTH * 2 * DFF * DM * 2);
constexpr size_t WS_WG = WS_WF2 + al256((size_t)DEPTH * DM * DFF * 2);
constexpr size_t WS_XN = WS_WG + al256((size_t)DEPTH * 2 * 8 * 64 * 64 * 2);
constexpr size_t WS_P = WS_XN + al256((size_t)SEQ * DM * 2);
constexpr size_t WS_MIX = WS_P + al256((size_t)SEQ * PN * 2);
constexpr size_t WS_U = WS_MIX + al256((size_t)SEQ * DM * 2);
constexpr size_t WS_HL = WS_U + al256((size_t)NCH * 32768 * 4);
constexpr size_t WS_DEC = WS_HL + al256((size_t)SEQ * DLRU * 4);
constexpr size_t WS_PT = WS_DEC + al256((size_t)NCH * 256 * 4);
constexpr size_t WS_HE = WS_PT + al256((size_t)NCH * DLRU * 4);
constexpr size_t WS_SS = WS_HE + al256((size_t)NCH * DLRU * 4);
constexpr size_t WS_BAR = WS_SS + al256((size_t)16 * SEQ * 4);
constexpr size_t WS_SB = WS_BAR + al256((size_t)XCD_BAR_WORDS * 4);
constexpr size_t WS_END = WS_SB + al256((size_t)NCH * 32768 * 2);
constexpr int WAVE_LDS = 18432, LDS_BYTES = 8 * WAVE_LDS;
static_assert(LDS_BYTES >= pg8::STAGE_BYTES, "lds");

struct Params {
    const float* x; const float* norm1; const float* w_in; const float* conv_w; const float* conv_b; const float* lru_wa; const float* lru_ba; const float* lru_wi; const float* lru_bi;
    const float* lru_lambda; const float* gla_w_alpha; const float* gla_b_alpha; const float* gla_norm; const float* w_out; const float* norm2; const float* w_ffn_in; const float* w_ffn_out; const float* final_norm;
    float* out; unsigned char* ws; int ph_lo, ph_hi;
};

__device__ __forceinline__ unsigned f2bf(float f) { unsigned u = __builtin_bit_cast(unsigned, f); return (u + 0x7fffu + ((u >> 16) & 1u)) >> 16; }
__device__ __forceinline__ float bf2f(unsigned short b) { return __builtin_bit_cast(float, ((unsigned)b) << 16); }
__device__ __forceinline__ float bflo(unsigned w) { return __builtin_bit_cast(float, w << 16); }
__device__ __forceinline__ float bfhi(unsigned w) { return __builtin_bit_cast(float, w & 0xffff0000u); }
__device__ __forceinline__ float fast_sigmoid(float x) { return __builtin_amdgcn_rcpf(1.0f + __builtin_amdgcn_exp2f(-1.4426950408889634f * x)); }
__device__ __forceinline__ float silu_f(float x) { return x * fast_sigmoid(x); }
__device__ __forceinline__ float gelu_tanh_f(float x) { const float y = 0.7978845608028654f * (x + 0.044715f * x * x * x); return x * fast_sigmoid(2.0f * y); }
#define MFMA16(a, b, c) __builtin_amdgcn_mfma_f32_16x16x32_bf16(a, b, c, 0, 0, 0)

__device__ __forceinline__ float row_rstd(const float* ssp, int row) {
    const f32x4 a = *(const f32x4*)(ssp + (size_t)row * 16), b = *(const f32x4*)(ssp + (size_t)row * 16 + 4), c = *(const f32x4*)(ssp + (size_t)row * 16 + 8), d = *(const f32x4*)(ssp + (size_t)row * 16 + 12);
    const float s = ((a[0] + a[1]) + (a[2] + a[3])) + ((b[0] + b[1]) + (b[2] + b[3])) + (((c[0] + c[1]) + (c[2] + c[3])) + ((d[0] + d[1]) + (d[2] + d[3])));
    return __builtin_amdgcn_rsqf(s * (1.0f / DM) + EPS); }
constexpr int RST_OFF = pg8::STAGE_BYTES;
template <class Sched> __device__ __forceinline__ void fill_rstd(LAS unsigned char* lds, const Sched& S, const float* ssp) {
    const int tid = opaque_tid(); LAS float* rst = (LAS float*)(lds + RST_OFF);
    for (int i = (tid >> 8); i < 8; i += 2) { pg8::Unit u; if (!S.next(i, u)) break; rst[i * 256 + (tid & 255)] = row_rstd(ssp, u.pm * 256 + (tid & 255)); }
    __syncthreads();
}
struct EpiStoreBf16 {
    static constexpr bool PERM = true, AFTER_DRAIN = false, INIT_ACC = false, HAS_PRE = true;
    bf16_t* O; int ldc; LAS float* rst; const float* ssp;
    template <class Sched> __device__ __forceinline__ void pre(const Sched& S) const {
        const int tid = opaque_tid();
        for (int i = (tid >> 8); i < 8; i += 2) { pg8::Unit u; if (!S.next(i, u)) break; rst[i * 256 + (tid & 255)] = row_rstd(ssp, u.pm * 256 + (tid & 255)); }
    }
    __device__ __forceinline__ void operator()(const f32x4 (&acc)[2][2][4][2], const pg8::Unit& u, int wr, int wc, int fr, int fq) const {
        const int row0 = u.pm * 256 + wr * 64 + fr, col0 = u.pn * 256 + wc * 32 + 8 * fq;
#pragma unroll
        for (int ai = 0; ai < 2; ++ai)
#pragma unroll
            for (int m = 0; m < 4; ++m) { const int row = row0 + ai * 128 + m * 16; const float rs = rst[u.ui * 256 + wr * 64 + fr + ai * 128 + m * 16]; bf16_t* rowp = O + (size_t)row * ldc + col0;
#pragma unroll
                for (int bj = 0; bj < 2; ++bj) { const f32x4 v0 = acc[ai][bj][m][0] * rs, v1 = acc[ai][bj][m][1] * rs;
                    u32x4 w; w.x = cvt_pk_bf16(v0[0], v0[1]); w.y = cvt_pk_bf16(v0[2], v0[3]); w.z = cvt_pk_bf16(v1[0], v1[1]); w.w = cvt_pk_bf16(v1[2], v1[3]);
                    *(u32x4*)(rowp + bj * 128) = w; } }
    }
};
struct EpiSwiglu {
    static constexpr bool PERM = true, AFTER_DRAIN = false, INIT_ACC = false, HAS_PRE = true;
    bf16_t* O; int ldc; LAS float* rst; const float* ssp;
    template <class Sched> __device__ __forceinline__ void pre(const Sched& S) const {
        const int tid = opaque_tid();
        for (int i = (tid >> 8); i < 8; i += 2) { pg8::Unit u; if (!S.next(i, u)) break; rst[i * 256 + (tid & 255)] = row_rstd(ssp, u.pm * 256 + (tid & 255)); }
    }
    __device__ __forceinline__ void operator()(const f32x4 (&acc)[2][2][4][2], const pg8::Unit& u, int wr, int wc, int fr, int fq) const {
        const int row0 = u.pm * 256 + wr * 64 + fr, col0 = u.pn * 128 + wc * 32 + 8 * fq;
#pragma unroll
        for (int ai = 0; ai < 2; ++ai)
#pragma unroll
            for (int m = 0; m < 4; ++m) { const int row = row0 + ai * 128 + m * 16; const float rs = rst[u.ui * 256 + wr * 64 + fr + ai * 128 + m * 16]; bf16_t* rowp = O + (size_t)row * ldc + col0;
                const float rs2 = rs * rs, c1 = -1.4426950408889634f * rs;
                const f32x4 g0 = acc[ai][0][m][0], g1 = acc[ai][0][m][1], u0 = acc[ai][1][m][0], u1 = acc[ai][1][m][1];
                const f32x4 t0 = g0 * c1, t1 = g1 * c1;
                f32x4 d0, d1;
#pragma unroll
                for (int j = 0; j < 4; ++j) { d0[j] = __builtin_amdgcn_exp2f(t0[j]); d1[j] = __builtin_amdgcn_exp2f(t1[j]); }
                d0 = d0 + 1.0f; d1 = d1 + 1.0f;
                f32x4 r0, r1;
#pragma unroll
                for (int j = 0; j < 4; ++j) { r0[j] = __builtin_amdgcn_rcpf(d0[j]); r1[j] = __builtin_amdgcn_rcpf(d1[j]); }
                const f32x4 v0 = ((g0 * u0) * rs2) * r0, v1 = ((g1 * u1) * rs2) * r1;
                u32x4 w; w.x = cvt_pk_bf16(v0[0], v0[1]); w.y = cvt_pk_bf16(v0[2], v0[3]); w.z = cvt_pk_bf16(v1[0], v1[1]); w.w = cvt_pk_bf16(v1[2], v1[3]);
                *(u32x4*)rowp = w; }
    }
};
struct EpiRes {
    static constexpr bool PERM = true, AFTER_DRAIN = false, INIT_ACC = true, HAS_PRE = false;
    bf16_t* xb; float* ss; int ldc;
    __device__ __forceinline__ void load_init(u32x4 (&raw)[2][4][2], const pg8::Unit& u, int wr, int wc, int fr, int fq) const {
        const int row0 = u.pm * 256 + wr * 64 + fr, col0 = u.pn * 256 + wc * 32 + 8 * fq;
#pragma unroll
        for (int ai = 0; ai < 2; ++ai)
#pragma unroll
            for (int m = 0; m < 4; ++m)
#pragma unroll
                for (int bj = 0; bj < 2; ++bj) raw[ai][m][bj] = *(const u32x4*)(xb + (size_t)(row0 + ai * 128 + m * 16) * ldc + col0 + bj * 128);
    }
    __device__ __forceinline__ void unpack_init(f32x4 (&acc)[2][2][4][2], const u32x4 (&raw)[2][4][2]) const {
#pragma unroll
        for (int ai = 0; ai < 2; ++ai)
#pragma unroll
            for (int m = 0; m < 4; ++m)
#pragma unroll
                for (int bj = 0; bj < 2; ++bj) { const u32x4 b = raw[ai][m][bj];
                    acc[ai][bj][m][0] = (f32x4){bflo(b.x), bfhi(b.x), bflo(b.y), bfhi(b.y)}; acc[ai][bj][m][1] = (f32x4){bflo(b.z), bfhi(b.z), bflo(b.w), bfhi(b.w)}; }
    }
    __device__ __forceinline__ void operator()(const f32x4 (&acc)[2][2][4][2], const pg8::Unit& u, int wr, int wc, int fr, int fq) const {
        const int row0 = u.pm * 256 + wr * 64 + fr, col0 = u.pn * 256 + wc * 32 + 8 * fq;
#pragma unroll
        for (int ai = 0; ai < 2; ++ai)
#pragma unroll
            for (int m = 0; m < 4; ++m) { const int row = row0 + ai * 128 + m * 16; const size_t off = (size_t)row * ldc + col0; float s = 0.f;
#pragma unroll
                for (int bj = 0; bj < 2; ++bj) { const f32x4 v0 = acc[ai][bj][m][0], v1 = acc[ai][bj][m][1];
                    u32x4 w; w.x = cvt_pk_bf16(v0[0], v0[1]); w.y = cvt_pk_bf16(v0[2], v0[3]); w.z = cvt_pk_bf16(v1[0], v1[1]); w.w = cvt_pk_bf16(v1[2], v1[3]);
                    *(u32x4*)(xb + off + bj * 128) = w;
                    s += v0[0] * v0[0] + v0[1] * v0[1] + v0[2] * v0[2] + v0[3] * v0[3] + v1[0] * v1[0] + v1[1] * v1[1] + v1[2] * v1[2] + v1[3] * v1[3]; }
                s += __shfl_xor(s, 16); s += __shfl_xor(s, 32);
                if (fq == 0) ss[(size_t)row * 16 + u.pn * 4 + wc] = s; }
    }
};

struct PrepTile { const float* src; const float* gain; bf16_t* dst; int ld, Kd, k0, n0, kind, l; };
__device__ __forceinline__ PrepTile prep_decode(const Params& p, int tix) {
    constexpr int T0 = 160, T1 = 16, T2 = 64, T3 = 352, T4 = 176, TL = T0 + T1 + T2 + T3 + T4;
    PrepTile t; const int l = tix / TL; int r = tix % TL; int kind;
    if (r < T0) kind = 0; else if ((r -= T0) < T1) kind = 1; else if ((r -= T1) < T2) kind = 2; else if ((r -= T2) < T3) kind = 3; else { r -= T3; kind = 4; }
    t.kind = kind; t.l = l; t.Kd = (kind == 4) ? DFF : DM; const int nkt = t.Kd / 64; t.k0 = (r % nkt) * 64; const int nt = r / nkt; t.n0 = nt * 256; t.gain = nullptr;
    if (kind == 0) { t.src = p.w_in + (size_t)l * DM * PIN + t.n0; t.ld = PIN; t.gain = p.norm1 + l * DM; t.dst = (bf16_t*)(p.ws + WS_WIN) + (size_t)l * PN * DM; }
    else if (kind == 1) { t.src = p.w_in + (size_t)l * DM * PIN + C_Z; t.ld = PIN; t.gain = p.norm1 + l * DM; t.dst = (bf16_t*)(p.ws + WS_WIN) + (size_t)l * PN * DM; t.n0 = C_Z; }
    else if (kind == 2) { t.src = p.w_out + (size_t)l * DM * DM + t.n0; t.ld = DM; t.dst = (bf16_t*)(p.ws + WS_WOUT) + (size_t)l * DM * DM; }
    else if (kind == 3) { t.src = p.w_ffn_in + (size_t)l * DM * 2 * DFF + 128 * nt; t.ld = 2 * DFF; t.gain = p.norm2 + l * DM; t.dst = (bf16_t*)(p.ws + WS_WF1) + (size_t)l * 2 * DFF * DM; }
    else { t.src = p.w_ffn_out + (size_t)l * DFF * DM + t.n0; t.ld = DM; t.dst = (bf16_t*)(p.ws + WS_WF2) + (size_t)l * DM * DFF; }
    return t;
}
__device__ __forceinline__ void prep_load(const Params& p, const PrepTile& t, int tid, f32x4 (&v)[8]) {
    const int n4 = (tid & 63) * 4, kw = tid >> 6;
    if (t.kind == 1) { const float* wa = p.gla_w_alpha + (size_t)t.l * 16 * 256 + n4;
#pragma unroll
        for (int i = 0; i < 8; ++i) v[i] = (f32x4){0.f, 0.f, 0.f, 0.f};
#pragma unroll
        for (int hf = 0; hf < 2; ++hf) { f32x4 a[8], z[8][2];
#pragma unroll
            for (int rr = 0; rr < 8; ++rr) a[rr] = *(const f32x4*)(wa + (hf * 8 + rr) * 256);
#pragma unroll
            for (int i = 0; i < 8; ++i) { const float* zr = t.src + (size_t)(t.k0 + i * 8 + kw) * t.ld + hf * 8; z[i][0] = *(const f32x4*)zr; z[i][1] = *(const f32x4*)(zr + 4); }
#pragma unroll
            for (int i = 0; i < 8; ++i)
#pragma unroll
                for (int rr = 0; rr < 8; ++rr) v[i] += a[rr] * z[i][rr >> 2][rr & 3]; }
    } else { const int sc = (t.kind == 3 && n4 >= 128) ? (DFF - 128 + n4) : n4;
#pragma unroll
        for (int i = 0; i < 8; ++i) v[i] = *(const f32x4*)(t.src + (size_t)(t.k0 + i * 8 + kw) * t.ld + sc); }
    if (t.gain) {
#pragma unroll
        for (int i = 0; i < 8; ++i) v[i] *= t.gain[t.k0 + i * 8 + kw]; }
}
__device__ __forceinline__ void prep_tiles(const Params& p, LAS unsigned char* lds, const int tile_lo, const int tile_hi, const int rank, const int nranks) {
    LAS float* T = (LAS float*)lds;
    const int tid = opaque_tid();
    int tix = tile_lo + rank; f32x4 v[8]; PrepTile t;
    if (tix < tile_hi) { t = prep_decode(p, tix); prep_load(p, t, tid, v); }
    while (tix < tile_hi) {
        { const int n4 = (tid & 63) * 4, kw = tid >> 6;
#pragma unroll
            for (int i = 0; i < 8; ++i) { LAS float* d = T + (i * 8 + kw) * 257 + n4; d[0] = v[i][0]; d[1] = v[i][1]; d[2] = v[i][2]; d[3] = v[i][3]; } }
        __syncthreads();
        const PrepTile cur = t; tix += nranks;
        if (tix < tile_hi) { t = prep_decode(p, tix); prep_load(p, t, tid, v); }
        { const int kseg = tid & 7;
#pragma unroll
            for (int ps = 0; ps < 4; ++ps) { const int n = ps * 64 + (tid >> 3); const LAS float* s = T + (8 * kseg) * 257 + n;
                u32x4 w; w.x = cvt_pk_bf16(s[0], s[257]); w.y = cvt_pk_bf16(s[2 * 257], s[3 * 257]); w.z = cvt_pk_bf16(s[4 * 257], s[5 * 257]); w.w = cvt_pk_bf16(s[6 * 257], s[7 * 257]);
                *(u32x4*)(cur.dst + (size_t)(cur.n0 + n) * cur.Kd + cur.k0 + 8 * kseg) = w; } }
        __syncthreads();
    }
}
template <class Sched> __device__ __forceinline__ void prep_in_tail(const Params& p, LAS unsigned char* lds, const Sched& S, const int tile_lo, const int tile_hi) {
    const int rem = S.nwg % S.G;
    if (rem == 0) prep_tiles(p, lds, tile_lo, tile_hi, S.c, S.G);
    else if (S.c >= rem) prep_tiles(p, lds, tile_lo, tile_hi, S.c - rem, S.G - rem);
}
__device__ __forceinline__ void prep_gates(const Params& p) {
    const int tid = opaque_tid();
    bf16_t* wg = (bf16_t*)(p.ws + WS_WG);
    for (int idx = blockIdx.x * 512 + tid; idx < DEPTH * 2 * 8 * 4096; idx += gridDim.x * 512) {
        const int i = idx & 63, j = (idx >> 6) & 63, blk = (idx >> 12) & 7, g = (idx >> 15) & 1, l = idx >> 16;
        const float* s = (g ? p.lru_wi : p.lru_wa) + (size_t)l * 8 * 4096 + blk * 4096 + i * 64 + j;
        wg[idx] = (bf16_t)f2bf(-1.4426950408889634f * *s);
    }
}

__device__ __forceinline__ void x_to_bf16(const float* X, bf16_t* XB, float* SS0) {
    const int tid = opaque_tid(), lane = tid & 63, gw = blockIdx.x * 8 + (tid >> 6), nw = gridDim.x * 8;
#pragma unroll 2
    for (int r = gw; r < SEQ; r += nw) {
        const float* xr = X + (size_t)r * DM; f32x4 v[4]; float s = 0.f;
#pragma unroll
        for (int i = 0; i < 4; ++i) { v[i] = *(const f32x4*)(xr + i * 256 + lane * 4); s += v[i][0] * v[i][0] + v[i][1] * v[i][1] + v[i][2] * v[i][2] + v[i][3] * v[i][3]; }
#pragma unroll
        for (int o = 32; o >= 1; o >>= 1) s += __shfl_xor(s, o);
        if (lane < 16) SS0[(size_t)r * 16 + lane] = (lane == 0) ? s : 0.f;
#pragma unroll
        for (int i = 0; i < 4; ++i) { u32x2 w; w.x = cvt_pk_bf16(v[i][0], v[i][1]); w.y = cvt_pk_bf16(v[i][2], v[i][3]); *(u32x2*)(XB + (size_t)r * DM + i * 256 + lane * 4) = w; }
    }
}
__device__ __forceinline__ void final_norm(const bf16_t* XB, float* OUT, const float* ss, const float* gain) {
    const int tid = opaque_tid();
    const bool grouped = gridDim.x == 256;
    const int step = grouped ? 512 * 4 : gridDim.x * 512 * 4, first = grouped ? (2048 * (blockIdx.x & 7) + 64 * (blockIdx.x >> 3)) * 128 : blockIdx.x * 512 * 4, last = grouped ? first + 4 * step : SEQ * DM / 8;
    for (int base = first; base < last; base += step) {
        u32x4 v[4];
#pragma unroll
        for (int i = 0; i < 4; ++i) v[i] = *(const u32x4*)(XB + (size_t)(base + i * 512 + tid) * 8);
#pragma unroll
        for (int i = 0; i < 4; ++i) { const int e = (base + i * 512 + tid) * 8, row = e >> 10, col = e & 1023; const float rs = row_rstd(ss, row);
            const f32x4 g0 = *(const f32x4*)(gain + col), g1 = *(const f32x4*)(gain + col + 4);
            *(f32x4*)(OUT + (size_t)e) = (f32x4){bflo(v[i].x), bfhi(v[i].x), bflo(v[i].y), bfhi(v[i].y)} * rs * g0;
            *(f32x4*)(OUT + (size_t)e + 4) = (f32x4){bflo(v[i].z), bfhi(v[i].z), bflo(v[i].w), bfhi(v[i].w)} * rs * g1; }
    }
}
#define WAVE_SYNC() do { asm volatile("s_waitcnt lgkmcnt(0)" ::: "memory"); __builtin_amdgcn_wave_barrier(); asm volatile("" ::: "memory"); } while (0)
__device__ __forceinline__ bf16x8 pack8(const float (&v)[8]) { u32x4 w; w.x = cvt_pk_bf16(v[0], v[1]); w.y = cvt_pk_bf16(v[2], v[3]); w.z = cvt_pk_bf16(v[4], v[5]); w.w = cvt_pk_bf16(v[6], v[7]); return __builtin_bit_cast(bf16x8, w); }

__device__ __forceinline__ void mixer_a(const Params& p, const int l, LAS unsigned char* lds) {
    const int tid = opaque_tid(), lane = tid & 63, w = __builtin_amdgcn_readfirstlane(tid >> 6), c = lane & 15, q = lane >> 4;
    LAS unsigned char* wl = lds + w * WAVE_LDS;
    LAS bf16_t* xs = (LAS bf16_t*)wl;
    LAS float* sa = (LAS float*)wl;
    LAS float* su = (LAS float*)(wl + 4096);
    LAS bf16_t* xcs = (LAS bf16_t*)(wl + 8704);
    LAS bf16_t* zs = (LAS bf16_t*)wl;
    LAS bf16_t* ks = (LAS bf16_t*)(wl + 8192);
    LAS bf16_t* kdT = (LAS bf16_t*)wl;
    LAS unsigned char* vt = wl + 9216;
    const bf16_t* P = (const bf16_t*)(p.ws + WS_P);
    unsigned* HL = (unsigned*)(p.ws + WS_HL);
    float* U = (float*)(p.ws + WS_U); float* DEC = (float*)(p.ws + WS_DEC); float* PT = (float*)(p.ws + WS_PT); float* HE = (float*)(p.ws + WS_HE);
    const int hh = w >> 1, half = w & 1, seg = lane & 7, rsub = lane >> 3;
    for (int ch0 = blockIdx.x; ch0 < NCH; ch0 += gridDim.x) { const int ch = (gridDim.x == 256) ? 32 * (ch0 & 7) + (ch0 >> 3) : ch0;
        const int t0 = ch * CHUNK;
        {   u32x4 xv[9];
#pragma unroll
            for (int it = 0; it < 9; ++it) { const int row = it * 8 + rsub, t = t0 - 3 + row; xv[it] = (u32x4){0u, 0u, 0u, 0u};
                if (row < 67 && t >= 0) xv[it] = *(const u32x4*)(P + (size_t)t * PN + 64 * w + 8 * seg); }
            const int gch = 64 * w + 8 * seg; f32x4 cwv[4][2], cbv[2];
#pragma unroll
            for (int j = 0; j < 4; ++j) { cwv[j][0] = *(const f32x4*)(p.conv_w + (size_t)(l * 4 + j) * DLRU + gch); cwv[j][1] = *(const f32x4*)(p.conv_w + (size_t)(l * 4 + j) * DLRU + gch + 4); }
            cbv[0] = *(const f32x4*)(p.conv_b + l * DLRU + gch); cbv[1] = *(const f32x4*)(p.conv_b + l * DLRU + gch + 4);
#pragma unroll
            for (int it = 0; it < 9; ++it) { const int row = it * 8 + rsub; if (row < 67) *(LAS u32x4*)(xs + row * 64 + 8 * seg) = xv[it]; }
            WAVE_SYNC();
#pragma unroll 1
            for (int i = 0; i < 8; ++i) { const int t = i * 8 + rsub; float xc[8];
#pragma unroll
                for (int e = 0; e < 4; ++e) { xc[e] = cbv[0][e]; xc[4 + e] = cbv[1][e]; }
#pragma unroll
                for (int j = 0; j < 4; ++j) { const u32x4 x4 = *(const LAS u32x4*)(xs + (t + j) * 64 + 8 * seg);
                    xc[0] += cwv[j][0][0] * bflo(x4.x); xc[1] += cwv[j][0][1] * bfhi(x4.x); xc[2] += cwv[j][0][2] * bflo(x4.y); xc[3] += cwv[j][0][3] * bfhi(x4.y);
                    xc[4] += cwv[j][1][0] * bflo(x4.z); xc[5] += cwv[j][1][1] * bfhi(x4.z); xc[6] += cwv[j][1][2] * bflo(x4.w); xc[7] += cwv[j][1][3] * bfhi(x4.w); }
                *(LAS bf16x8*)(xcs + t * 64 + 8 * seg) = pack8(xc); }
            WAVE_SYNC();
        }
        const bf16_t* wg = (const bf16_t*)(p.ws + WS_WG) + (size_t)((l * 2) * 8 + w) * 4096;
        bf16x8 Bw[2][4][2];
#pragma unroll
        for (int g = 0; g < 2; ++g)
#pragma unroll
            for (int nt = 0; nt < 4; ++nt)
#pragma unroll
                for (int k2 = 0; k2 < 2; ++k2) Bw[g][nt][k2] = *(const bf16x8*)(wg + (size_t)g * 8 * 4096 + (16 * nt + c) * 64 + 32 * k2 + 8 * q);
        float ba[4], bi[4], sp[4];
#pragma unroll
        for (int nt = 0; nt < 4; ++nt) { const int gch = 64 * w + 16 * nt + c; ba[nt] = -1.4426950408889634f * p.lru_ba[l * DLRU + gch]; bi[nt] = -1.4426950408889634f * p.lru_bi[l * DLRU + gch]; sp[nt] = -8.0f * 1.4426950408889634f * __logf(1.0f + __expf(-p.lru_lambda[l * DLRU + gch])); }
        float hst = 0.f, cp = 1.f;
#pragma unroll 1
        for (int mt = 0; mt < 4; ++mt) {
            const bf16x8 Af0 = *(const LAS bf16x8*)(xcs + (16 * mt + c) * 64 + 8 * q), Af1 = *(const LAS bf16x8*)(xcs + (16 * mt + c) * 64 + 32 + 8 * q);
#pragma unroll
            for (int nt = 0; nt < 4; ++nt) { const int chl = 16 * nt + c;
                f32x4 racc = {ba[nt], ba[nt], ba[nt], ba[nt]}, iacc = {bi[nt], bi[nt], bi[nt], bi[nt]};
                racc = MFMA16(Af0, Bw[0][nt][0], racc); racc = MFMA16(Af1, Bw[0][nt][1], racc); iacc = MFMA16(Af0, Bw[1][nt][0], iacc); iacc = MFMA16(Af1, Bw[1][nt][1], iacc);
#pragma unroll
                for (int reg = 0; reg < 4; ++reg) {
                    const float xc = bf2f(xcs[(16 * mt + 4 * q + reg) * 64 + chl]);
                    const float r = __builtin_amdgcn_rcpf(1.0f + __builtin_amdgcn_exp2f(racc[reg])), ig = __builtin_amdgcn_rcpf(1.0f + __builtin_amdgcn_exp2f(iacc[reg]));
                    const float a = __builtin_amdgcn_exp2f(sp[nt] * r);
                    const float om = __builtin_fmaf(-a, a, 1.0f);
                    sa[(4 * q + reg) * 64 + chl] = a; su[(4 * q + reg) * 64 + chl] = __builtin_amdgcn_sqrtf(om) * ig * xc; } }
            WAVE_SYNC();
            unsigned* hl = HL + (size_t)(t0 + 16 * mt) * DLRU + 64 * w + lane;
#pragma unroll
            for (int tt = 0; tt < 16; ++tt) { const float a = sa[tt * 64 + lane], u = su[tt * 64 + lane]; hst = a * hst + u; cp *= a; hl[(size_t)tt * DLRU] = cvt_pk_bf16(hst, cp); }
            WAVE_SYNC();
        }
        PT[ch * DLRU + 64 * w + lane] = cp; HE[ch * DLRU + 64 * w + lane] = hst;
        WAVE_SYNC();
        {   const int gc = 64 * hh + lane; const float zb = p.gla_b_alpha[l * 256 + gc];
            u32x4 zv[8], kv[8], vv[8];
#pragma unroll
            for (int it = 0; it < 8; ++it) { const bf16_t* row = P + (size_t)(t0 + it * 8 + rsub) * PN;
                zv[it] = *(const u32x4*)(row + C_Z + 64 * hh + 8 * seg); kv[it] = *(const u32x4*)(row + C_K + 64 * hh + 8 * seg); vv[it] = *(const u32x4*)(row + C_V + 128 * hh + 64 * half + 8 * seg); }
#pragma unroll
            for (int it = 0; it < 8; ++it) { *(LAS u32x4*)(zs + (it * 8 + rsub) * 64 + 8 * seg) = zv[it]; *(LAS u32x4*)(ks + (it * 8 + rsub) * 64 + 8 * seg) = kv[it]; }
            WAVE_SYNC();
            bf16x8 kdp[8]; float suf = 0.f;
#pragma unroll
            for (int t8 = 7; t8 >= 0; --t8) { float kd[8];
#pragma unroll
                for (int e = 7; e >= 0; --e) { const int t = 8 * t8 + e;
                    const float z = bf2f(zs[t * 64 + lane]) + zb, kk = bf2f(ks[t * 64 + lane]);
                    const float la = (fminf(z, 0.f) - __logf(1.0f + __expf(-fabsf(z)))) * 0.0625f;
                    kd[e] = kk * __expf(suf); suf += la; }
                kdp[t8] = pack8(kd); }
            if (half == 0) DEC[ch * 256 + gc] = __expf(suf);
            WAVE_SYNC();
#pragma unroll
            for (int t8 = 0; t8 < 8; ++t8) *(LAS bf16x8*)(kdT + lane * 72 + 8 * t8) = kdp[t8];
#pragma unroll
            for (int it = 0; it < 8; ++it) { LAS unsigned char* dst = vt + (it * 8 + rsub) * 136 + 16 * seg; *(LAS u32x2*)dst = (u32x2){vv[it].x, vv[it].y}; *(LAS u32x2*)(dst + 8) = (u32x2){vv[it].z, vv[it].w}; }
            WAVE_SYNC();
        }
        {   bf16x8 Ak[4][2];
#pragma unroll
            for (int mt = 0; mt < 4; ++mt)
#pragma unroll
                for (int k2 = 0; k2 < 2; ++k2) Ak[mt][k2] = *(const LAS bf16x8*)(kdT + (16 * mt + c) * 72 + 32 * k2 + 8 * q);
            float* Uc = U + (size_t)(ch * 4 + hh) * 64 * 128;
#pragma unroll
            for (int nt = 0; nt < 4; ++nt) { const int vl = 16 * nt + c, vcol = 64 * half + vl; bf16x8 Bv[2];
#pragma unroll
                for (int k2 = 0; k2 < 2; ++k2) { unsigned short tmp[8];
#pragma unroll
                    for (int e = 0; e < 8; ++e) tmp[e] = *(const LAS unsigned short*)(vt + (32 * k2 + 8 * q + e) * 136 + 2 * vl);
                    u32x4 wv; wv.x = tmp[0] | ((unsigned)tmp[1] << 16); wv.y = tmp[2] | ((unsigned)tmp[3] << 16); wv.z = tmp[4] | ((unsigned)tmp[5] << 16); wv.w = tmp[6] | ((unsigned)tmp[7] << 16);
                    Bv[k2] = __builtin_bit_cast(bf16x8, wv); }
#pragma unroll
                for (int mt = 0; mt < 4; ++mt) { f32x4 acc = {0.f, 0.f, 0.f, 0.f}; acc = MFMA16(Ak[mt][0], Bv[0], acc); acc = MFMA16(Ak[mt][1], Bv[1], acc);
                    *(f32x4*)(Uc + (size_t)vcol * 64 + 16 * mt + 4 * q) = acc; } } }
        __syncthreads();
    }
}

__device__ __forceinline__ void scan_phase(const Params& p, LAS unsigned char* lds) {
    LAS float* sx = (LAS float*)lds; LAS float* sd = sx + 512;
    const int tid = opaque_tid(), i = tid & 127, seg = tid >> 7;
    float* U = (float*)(p.ws + WS_U); const float* DEC = (const float*)(p.ws + WS_DEC); const float* PT = (const float*)(p.ws + WS_PT); float* HE = (float*)(p.ws + WS_HE);
    for (int vb = blockIdx.x; vb < 260; vb += gridDim.x) {
        const float* Dp; float* Up; size_t ds, us;
        if (vb < 256) { const int e = vb * 128 + i; Dp = DEC + ((e >> 13) << 6) + (e & 63); ds = 256; Up = U + e; us = 32768; }
        else { const int chn = (vb - 256) * 128 + i; Dp = PT + chn; ds = 512; Up = HE + chn; us = 512; }
        Dp += (size_t)seg * 64 * ds; Up += (size_t)seg * 64 * us;
        float d[64], u[64];
        { const float* dq = Dp; const float* uq = Up;
#pragma unroll
            for (int j = 0; j < 64; ++j) { d[j] = *dq; u[j] = *uq; dq += ds; uq += us; asm volatile("" : "+v"(dq), "+v"(uq)); } }
        float x = 0.f, dp = 1.f;
#pragma unroll
        for (int j = 0; j < 64; ++j) { x = d[j] * x + u[j]; dp *= d[j]; }
        sx[seg * 128 + i] = x; sd[seg * 128 + i] = dp;
        __syncthreads();
        float carry = 0.f;
        for (int s2 = 0; s2 < seg; ++s2) carry = sd[s2 * 128 + i] * carry + sx[s2 * 128 + i];
        x = carry;
        if (vb < 256) { bf16_t* sq = (bf16_t*)(p.ws + WS_SB) + (size_t)seg * 64 * 32768 + vb * 128 + i;
#pragma unroll
            for (int j = 0; j < 64; ++j) { x = d[j] * x + u[j]; *sq = (bf16_t)f2bf(x); sq += 32768; asm volatile("" : "+v"(sq)); } }
        else { float* uq = Up;
#pragma unroll
            for (int j = 0; j < 64; ++j) { x = d[j] * x + u[j]; *uq = x; uq += us; asm volatile("" : "+v"(uq)); } }
        __syncthreads();
    }
}

__device__ __forceinline__ void mixer_b(const Params& p, const int l, LAS unsigned char* lds) {
    const int tid = opaque_tid(), lane = tid & 63, w = __builtin_amdgcn_readfirstlane(tid >> 6), c = lane & 15, q = lane >> 4;
    LAS float* red = (LAS float*)lds;
    const bf16_t* P = (const bf16_t*)(p.ws + WS_P); bf16_t* MIX = (bf16_t*)(p.ws + WS_MIX);
    const unsigned* HL = (const unsigned*)(p.ws + WS_HL); const float* U = (const float*)(p.ws + WS_U); const float* HE = (const float*)(p.ws + WS_HE);
    const int hh = w >> 1, half = w & 1;
    for (int ch0 = blockIdx.x; ch0 < NCH; ch0 += gridDim.x) { const int ch = (gridDim.x == 256) ? 32 * (ch0 & 7) + (ch0 >> 3) : ch0;
        const int t0 = ch * CHUNK;
        const bf16_t* ST = (const bf16_t*)(p.ws + WS_SB) + (size_t)(ch * 4 + hh) * 8192 + (size_t)(64 * half + c) * 64 + 8 * q;
        bf16x8 As[4][2];
#pragma unroll
        for (int mt = 0; mt < 4; ++mt)
#pragma unroll
            for (int k2 = 0; k2 < 2; ++k2) As[mt][k2] = *(const bf16x8*)(ST + (size_t)(16 * mt) * 64 + 32 * k2);
        bf16x8 Bq[4][2];
#pragma unroll
        for (int nt = 0; nt < 4; ++nt)
#pragma unroll
            for (int k2 = 0; k2 < 2; ++k2) Bq[nt][k2] = *(const bf16x8*)(P + (size_t)(t0 + 16 * nt + c) * PN + C_Q + 64 * hh + 32 * k2 + 8 * q);
        f32x4 acc[4][4];
#pragma unroll
        for (int mt = 0; mt < 4; ++mt) { const bf16x8 As0 = As[mt][0], As1 = As[mt][1];
#pragma unroll
            for (int nt = 0; nt < 4; ++nt) { f32x4 a = {0.f, 0.f, 0.f, 0.f}; a = MFMA16(As0, Bq[nt][0], a); a = MFMA16(As1, Bq[nt][1], a); acc[mt][nt] = a * 0.125f; } }
        u32x2 gv[4][4];
#pragma unroll
        for (int mt = 0; mt < 4; ++mt)
#pragma unroll
            for (int nt = 0; nt < 4; ++nt) gv[mt][nt] = *(const u32x2*)(P + (size_t)(t0 + 16 * nt + c) * PN + C_G + 128 * hh + 64 * half + 16 * mt + 4 * q);
        float rstd[4];
#pragma unroll
        for (int nt = 0; nt < 4; ++nt) { float s = 0.f;
#pragma unroll
            for (int mt = 0; mt < 4; ++mt) { const f32x4 a = acc[mt][nt]; s += a[0] * a[0] + a[1] * a[1] + a[2] * a[2] + a[3] * a[3]; }
            s += __shfl_xor(s, 16); s += __shfl_xor(s, 32);
            if (q == 0) red[w * 64 + 16 * nt + c] = s; }
        __syncthreads();
#pragma unroll
        for (int nt = 0; nt < 4; ++nt) rstd[nt] = __builtin_amdgcn_rsqf((red[w * 64 + 16 * nt + c] + red[(w ^ 1) * 64 + 16 * nt + c]) * (1.0f / 128.0f) + EPS);
#pragma unroll
        for (int mt = 0; mt < 4; ++mt) { const int v0 = 64 * half + 16 * mt + 4 * q; const f32x4 gn = *(const f32x4*)(p.gla_norm + l * 128 + v0);
#pragma unroll
            for (int nt = 0; nt < 4; ++nt) { const size_t tok = (size_t)(t0 + 16 * nt + c);
                const f32x4 a = acc[mt][nt]; const float rs = rstd[nt]; const u32x2 g2 = gv[mt][nt];
                const float o0 = a[0] * rs * gn[0] * silu_f(bflo(g2.x)), o1 = a[1] * rs * gn[1] * silu_f(bfhi(g2.x)), o2 = a[2] * rs * gn[2] * silu_f(bflo(g2.y)), o3 = a[3] * rs * gn[3] * silu_f(bfhi(g2.y));
                u32x2 ov; ov.x = cvt_pk_bf16(o0, o1); ov.y = cvt_pk_bf16(o2, o3);
                *(u32x2*)(MIX + tok * DM + 512 + 128 * hh + v0) = ov; } }
#pragma unroll 1
        for (int it0 = 0; it0 < 8; it0 += 4) { u32x4 h0[4], h1[4], g4[4]; f32x4 ci0[4], ci1[4];
#pragma unroll
            for (int j = 0; j < 4; ++j) { const int idx = (it0 + j) * 512 + tid, t = idx >> 6, c8 = (idx & 63) * 8; const size_t tok = (size_t)(t0 + t);
                h0[j] = *(const u32x4*)(HL + tok * DLRU + c8); h1[j] = *(const u32x4*)(HL + tok * DLRU + c8 + 4); g4[j] = *(const u32x4*)(P + tok * PN + C_LG + c8);
                ci0[j] = (f32x4){0.f, 0.f, 0.f, 0.f}; ci1[j] = (f32x4){0.f, 0.f, 0.f, 0.f};
                if (ch > 0) { ci0[j] = *(const f32x4*)(HE + (size_t)(ch - 1) * DLRU + c8); ci1[j] = *(const f32x4*)(HE + (size_t)(ch - 1) * DLRU + c8 + 4); } }
#pragma unroll
            for (int j = 0; j < 4; ++j) { const int idx = (it0 + j) * 512 + tid, t = idx >> 6, c8 = (idx & 63) * 8; const size_t tok = (size_t)(t0 + t); float o[8];
                o[0] = (bflo(h0[j].x) + bfhi(h0[j].x) * ci0[j][0]) * gelu_tanh_f(bflo(g4[j].x)); o[1] = (bflo(h0[j].y) + bfhi(h0[j].y) * ci0[j][1]) * gelu_tanh_f(bfhi(g4[j].x));
                o[2] = (bflo(h0[j].z) + bfhi(h0[j].z) * ci0[j][2]) * gelu_tanh_f(bflo(g4[j].y)); o[3] = (bflo(h0[j].w) + bfhi(h0[j].w) * ci0[j][3]) * gelu_tanh_f(bfhi(g4[j].y));
                o[4] = (bflo(h1[j].x) + bfhi(h1[j].x) * ci1[j][0]) * gelu_tanh_f(bflo(g4[j].z)); o[5] = (bflo(h1[j].y) + bfhi(h1[j].y) * ci1[j][1]) * gelu_tanh_f(bfhi(g4[j].z));
                o[6] = (bflo(h1[j].z) + bfhi(h1[j].z) * ci1[j][2]) * gelu_tanh_f(bflo(g4[j].w)); o[7] = (bflo(h1[j].w) + bfhi(h1[j].w) * ci1[j][3]) * gelu_tanh_f(bfhi(g4[j].w));
                *(bf16x8*)(MIX + tok * DM + c8) = pack8(o); } }
        __syncthreads();
    }
}
#ifndef EN
#define EN 0xFFFF
#endif
constexpr int LDS_TOTAL = LDS_BYTES + 16;
#ifndef USE_CG
#define USE_CG 0
#endif
#ifndef INK_DUP
#define INK_DUP 0
#endif
#ifndef DUP_MASK
#define DUP_MASK 0
#endif
__device__ __forceinline__ void group_barrier(unsigned* bar, unsigned* cnt) {
    asm volatile("s_waitcnt vmcnt(0)" ::: "memory");
    __syncthreads();
    if (threadIdx.x == 0) {
        __builtin_amdgcn_fence(__ATOMIC_RELEASE, "agent"); asm volatile("s_waitcnt vmcnt(0)" ::: "memory");
        const unsigned old = xb_add(cnt, 1u), target = (old / 32u + 1u) * 32u;
        XB_SPIN(xb_ld(cnt) < target, bar);
        __builtin_amdgcn_fence(__ATOMIC_ACQUIRE, "agent"); asm volatile("s_waitcnt vmcnt(0)" ::: "memory");
    }
    __syncthreads();
}
constexpr int N_PHASES = 1 + 7 * DEPTH + 1;
__global__ void __launch_bounds__(512, 2) fwd_kernel(Params p) {
    extern __shared__ __attribute__((aligned(16))) unsigned char lds_raw[];
    LAS unsigned char* lds = (LAS unsigned char*)lds_raw;
    cg::grid_group grid = cg::this_grid();
    const bool fused = (p.ph_hi - p.ph_lo) > 1;
    volatile LAS unsigned* st = (volatile LAS unsigned*)(lds + LDS_BYTES);
    XcdBarrier bar; bar.bar = (unsigned*)(p.ws + WS_BAR); bar.x = 0; bar.st = st;
    if (fused) { if (threadIdx.x < 4) st[threadIdx.x] = 0u; __syncthreads(); bar = xcd_barrier_post((unsigned*)(p.ws + WS_BAR), st); }
    int ph = 0;
#define RUN(ph_) ((ph_) >= p.ph_lo && (ph_) < p.ph_hi)
#define SEAM(ph_) do { if ((ph_) + 1 < p.ph_hi) { if (USE_CG || p.ph_hi > 4096) grid.sync(); else xcd_barrier(bar); } } while (0)
#define SEAM_G(ph_) do { if ((ph_) + 1 < p.ph_hi) { if (!USE_CG && gridDim.x == 256) group_barrier(bar.bar, bar.bar + 16u * (blockIdx.x & 7u)); else { SEAM(ph_); } } } while (0)
    bf16_t* XB = (bf16_t*)(p.ws + WS_XN); bf16_t* Pb = (bf16_t*)(p.ws + WS_P); bf16_t* MIX = (bf16_t*)(p.ws + WS_MIX); float* SS = (float*)(p.ws + WS_SS);
    if (RUN(ph)) { if (EN & 1) { prep_tiles(p, lds, 0, 768, (int)blockIdx.x, (int)gridDim.x); prep_gates(p); x_to_bf16(p.x, XB, SS); }   SEAM(ph); } ++ph;
#pragma unroll 1
    for (int l = 0; l < DEPTH; ++l) {
        if (RUN(ph)) { pg8::Gemm g{XB, (const bf16_t*)(p.ws + WS_WIN) + (size_t)l * PN * DM, SEQ, PN, DM}; pg8::StaticOrder S; S.init(SEQ, PN, (int)gridDim.x, (int)blockIdx.x);
            EpiStoreBf16 E{Pb, PN, (LAS float*)(lds + RST_OFF), SS}; if (EN & 32) pg8::gemm_phase<EpiStoreBf16, pg8::StaticOrder, true, true>(lds, g, S, E);
            if (l + 1 < DEPTH) prep_in_tail(p, lds, S, (l + 1) * 768, (l + 1) * 768 + 256); SEAM(ph); } ++ph;
        if (RUN(ph)) { if (EN & 4) { mixer_a(p, l, lds); if (INK_DUP & 4) mixer_a(p, l, lds); } SEAM(ph); } ++ph;
        if (RUN(ph)) { if (EN & 8) scan_phase(p, lds); SEAM(ph); } ++ph;
        if (RUN(ph)) { if (EN & 16) { mixer_b(p, l, lds); if (INK_DUP & 16) mixer_b(p, l, lds); } SEAM_G(ph); } ++ph;
        if (RUN(ph)) { pg8::Gemm g{MIX, (const bf16_t*)(p.ws + WS_WOUT) + (size_t)l * DM * DM, SEQ, DM, DM}; pg8::StaticOrder S; S.init(SEQ, DM, (int)gridDim.x, (int)blockIdx.x);
            EpiRes E{XB, SS, DM}; if (EN & 64) pg8::gemm_phase<EpiRes, pg8::StaticOrder, false, true>(lds, g, S, E); SEAM_G(ph); } ++ph;
        if (RUN(ph)) { pg8::Gemm g{XB, (const bf16_t*)(p.ws + WS_WF1) + (size_t)l * 2 * DFF * DM, SEQ, 2 * DFF, DM}; pg8::StaticOrder S; S.init(SEQ, 2 * DFF, (int)gridDim.x, (int)blockIdx.x);
            EpiSwiglu E{Pb, DFF, (LAS float*)(lds + RST_OFF), SS}; if (EN & 128) pg8::gemm_phase<EpiSwiglu, pg8::StaticOrder, true, true>(lds, g, S, E);
            if (l + 1 < DEPTH) prep_in_tail(p, lds, S, (l + 1) * 768 + 256, (l + 2) * 768); SEAM_G(ph); } ++ph;
        if (RUN(ph)) { pg8::Gemm g{Pb, (const bf16_t*)(p.ws + WS_WF2) + (size_t)l * DM * DFF, SEQ, DM, DFF}; pg8::StaticOrder S; S.init(SEQ, DM, (int)gridDim.x, (int)blockIdx.x);
            EpiRes E{XB, SS, DM}; if (EN & 256) pg8::gemm_phase<EpiRes, pg8::StaticOrder, false, true>(lds, g, S, E); SEAM_G(ph); } ++ph;
    }
    if (RUN(ph)) { final_norm(XB, p.out, SS, p.final_norm); } ++ph;
}

extern "C" void kernel_launch(void* const* d_in, const int* in_sizes, int n_in, void* d_out, int out_size, void* d_ws, size_t ws_size, hipStream_t stream) {
    static int grid = 0;
    if (grid == 0) {
        if (n_in != 18 || in_sizes[0] != SEQ * DM || out_size != SEQ * DM || ws_size < WS_END) { fprintf(stderr, "kernel_launch: unexpected shapes / workspace (n_in %d, ws %zu < %zu)\n", n_in, ws_size, (size_t)WS_END); grid = -1; return; }
        int dev = 0, cus = 0, per_cu = 0;
        hipGetDevice(&dev); hipDeviceGetAttribute(&cus, hipDeviceAttributeMultiprocessorCount, dev);
        if (hipFuncSetAttribute((const void*)fwd_kernel, hipFuncAttributeMaxDynamicSharedMemorySize, LDS_TOTAL) != hipSuccess) { fprintf(stderr, "kernel_launch: hipFuncSetAttribute failed\n"); grid = -1; return; }
        if (hipOccupancyMaxActiveBlocksPerMultiprocessor(&per_cu, (const void*)fwd_kernel, 512, LDS_TOTAL) != hipSuccess || per_cu < 1) { fprintf(stderr, "kernel_launch: occupancy query says %d blocks per CU\n", per_cu); (void)hipGetLastError(); per_cu = 1; }
        grid = cus * 1;
        fprintf(stderr, "kernel_launch: grid %d (cus %d, per_cu %d)\n", grid, cus, per_cu);
    }
    if (grid < 0) return;
    Params p{};
    p.x = (const float*)d_in[0]; p.norm1 = (const float*)d_in[1]; p.w_in = (const float*)d_in[2]; p.conv_w = (const float*)d_in[3]; p.conv_b = (const float*)d_in[4];
    p.lru_wa = (const float*)d_in[5]; p.lru_ba = (const float*)d_in[6]; p.lru_wi = (const float*)d_in[7]; p.lru_bi = (const float*)d_in[8]; p.lru_lambda = (const float*)d_in[9];
    p.gla_w_alpha = (const float*)d_in[10]; p.gla_b_alpha = (const float*)d_in[11]; p.gla_norm = (const float*)d_in[12]; p.w_out = (const float*)d_in[13]; p.norm2 = (const float*)d_in[14];
    p.w_ffn_in = (const float*)d_in[15]; p.w_ffn_out = (const float*)d_in[16]; p.final_norm = (const float*)d_in[17];
    p.out = (float*)d_out; p.ws = (unsigned char*)d_ws;
#if SINGLE_LAUNCH
    p.ph_lo = 0; p.ph_hi = N_PHASES;
    (void)hipMemsetAsync((unsigned char*)d_ws + WS_BAR, 0, (size_t)XCD_BAR_WORDS * 4, stream);
    void* args[] = {&p};
    hipError_t e = hipLaunchCooperativeKernel((const void*)fwd_kernel, dim3(grid), dim3(512), args, LDS_TOTAL, stream);
    if (e != hipSuccess) fprintf(stderr, "cooperative launch failed: %s (grid %d)\n", hipGetErrorString(e), grid);
#else
    for (int i = 0; i < N_PHASES; ++i) { p.ph_lo = i; p.ph_hi = i + 1; const int kind = (i == 0) ? 0 : (i == N_PHASES - 1) ? 10 : 1 + (i - 1) % 7;
        const int reps = ((DUP_MASK >> kind) & 1) ? 2 : 1;
        for (int r = 0; r < reps; ++r) hipLaunchKernelGGL(fwd_kernel, dim3(grid), dim3(512), LDS_TOTAL, stream, p); }
#endif
}
```

```cpp
#include <hip/hip_runtime.h>
#include <hip/hip_cooperative_groups.h>
#include <cstdio>
namespace cg = cooperative_groups;
#ifndef SINGLE_LAUNCH
#define SINGLE_LAUNCH 1
#endif
__device__ __forceinline__ int opaque_tid() { int t = threadIdx.x; asm volatile("" : "+v"(t)); return t; }
namespace pg8 {
#define PG8_LAS __attribute__((address_space(3)))
typedef unsigned short bf16_t;
typedef short bf16x8 __attribute__((ext_vector_type(8)));
typedef float f32x4 __attribute__((ext_vector_type(4)));
typedef unsigned u32x4 __attribute__((ext_vector_type(4)));
constexpr int BM = 256, BK = 64, HALF = 128, HTB = HALF * BK * 2  , STAGE_BYTES = 8 * HTB, NXCD = 8, WGM = 8;

__host__ __device__ __forceinline__ int lds_byte(int r, int c) { const int st = (r >> 4) * 2 + (c >> 5), rr = r & 15, cc = c & 31, ob = rr * 64 + cc * 2; return st * 1024 + (ob ^ (((ob >> 9) & 1) << 5)); }
__host__ __device__ __forceinline__ void stage_rc(int b, int& R, int& C) { const int st = b / 1024, sb = b % 1024, swz = sb ^ (((sb >> 9) & 1) << 5); R = (st >> 1) * 16 + swz / 64; C = (st & 1) * 32 + (swz % 64) / 2; }
__host__ __device__ __forceinline__ int perm32(int rho) { const int n = rho >> 4, i = rho & 15; return 8 * (i >> 2) + 4 * n + (i & 3); }

struct Unit { int pm, pn, ui; };
struct Gemm { const bf16_t* A; const bf16_t* Bt; int M, N, K; };

struct StaticOrder {
    int nM, nN, nwg, G, c;
    __host__ __device__ void init(int M, int N, int G_, int c_) { nM = M / BM; nN = N / BM; nwg = nM * nN; G = G_; c = c_; }
    __host__ __device__ bool next(int i, Unit& u) const {
        const long L = (long)i * G + c; if (L >= nwg) return false;
        int wgid = (int)L; { const int q = nwg / NXCD, r = nwg % NXCD, xcd = wgid % NXCD, off = wgid / NXCD; wgid = (xcd < r ? xcd * (q + 1) : r * (q + 1) + (xcd - r) * q) + off; }
        const int nig = WGM * nN, gid = wgid / nig, fm = gid * WGM, gsz = (nM - fm) < WGM ? (nM - fm) : WGM;
        u.pm = fm + ((wgid % nig) % gsz); u.pn = (wgid % nig) / gsz; u.ui = i; return true;
    }
    __device__ __forceinline__ void a_ready(const Unit&) const {}
    __device__ __forceinline__ void done(const Unit&) const {}
};
__device__ __forceinline__ unsigned cvt_pk_bf16(float lo, float hi) { unsigned r; asm volatile("v_cvt_pk_bf16_f32 %0, %1, %2" : "=v"(r) : "v"(lo), "v"(hi)); return r; }
template <class Epi, class Sched, bool ALIGN_EPI = false, bool SP2 = false>
__device__ __forceinline__ void gemm_phase(PG8_LAS unsigned char* lds, const Gemm g, const Sched& S, const Epi& E) {
    const int tid = opaque_tid(), wid = __builtin_amdgcn_readfirstlane(tid >> 6), lane = tid & 63, wr = wid >> 2, wc = wid & 3, fr = lane & 15, fq = lane >> 4;
    const int K = g.K, nt = K / BK;
    unsigned voffA[2], voffB[2];
#pragma unroll
    for (int i = 0; i < 2; ++i) { int R, C; stage_rc(tid * 16 + i * 8192, R, C); const int Rb = Epi::PERM ? ((R & ~31) + perm32(R & 31)) : R;
        voffA[i] = (unsigned)(R * K + C) * 2u; voffB[i] = (unsigned)(Rb * K + C) * 2u; }
    const size_t kstep = (size_t)(BK * 2);
    const size_t hstep = (size_t)HALF * K * 2;
    const size_t tstep = 2 * hstep;
    const unsigned ldsw = (unsigned)wid * 1024u;
    const int aoff = lds_byte(wr * 64 + fr, fq * 8), boff = lds_byte(wc * 32 + fr, fq * 8);
#define PG8_SA(b, h) (((b) * 2 + (h)) * HTB)
#define PG8_SB(b, h) ((4 + (b) * 2 + (h)) * HTB)
#define PG8_STAGE(bufoff, gbase, voff) do { _Pragma("unroll") for (int _i = 0; _i < 2; ++_i) \
        __builtin_amdgcn_global_load_lds((const unsigned*)((const char*)(gbase) + (voff)[_i]), (PG8_LAS unsigned*)(lds + (bufoff) + ldsw + _i * 8192), 16, 0, 0); } while (0)
#define PG8_LDA(dst, b, h) do { _Pragma("unroll") for (int m = 0; m < 4; ++m) _Pragma("unroll") for (int k = 0; k < 2; ++k) dst[m][k] = *(const PG8_LAS bf16x8*)(lds + PG8_SA(b, h) + aoff + m * 2048 + k * 1024); } while (0)
#define PG8_LDB(dst, b, h) do { _Pragma("unroll") for (int n = 0; n < 2; ++n) _Pragma("unroll") for (int k = 0; k < 2; ++k) dst[n][k] = *(const PG8_LAS bf16x8*)(lds + PG8_SB(b, h) + boff + n * 2048 + k * 1024); } while (0)
#define PG8_MMA(ai, bj, At, Bt) do { __builtin_amdgcn_s_setprio(1); _Pragma("unroll") for (int m = 0; m < 4; ++m) _Pragma("unroll") for (int n = 0; n < 2; ++n) _Pragma("unroll") for (int k = 0; k < 2; ++k) \
        acc[ai][bj][m][n] = __builtin_amdgcn_mfma_f32_16x16x32_bf16(Bt[n][k], At[m][k], acc[ai][bj][m][n], 0, 0, 0); __builtin_amdgcn_s_setprio(0); } while (0)
#define PG8_WAIT_V(n) asm volatile("s_waitcnt vmcnt(" #n ")" ::: "memory")
#define PG8_WAIT_L(n) asm volatile("s_waitcnt lgkmcnt(" #n ")" ::: "memory")
#define PG8_BAR __builtin_amdgcn_s_barrier()
#define PG8_SCHED __builtin_amdgcn_sched_barrier(0)
    Unit cur, nxt; int ui = 0;
    if (!S.next(0, cur)) return;
    f32x4 acc[2][2][4][2];
    u32x4 raw_init[2][4][2];
    if constexpr (Epi::INIT_ACC) E.load_init(raw_init, cur, wr, wc, fr, fq);
    else {
#pragma unroll
    for (int a = 0; a < 2; ++a)
#pragma unroll
        for (int b = 0; b < 2; ++b)
#pragma unroll
            for (int m = 0; m < 4; ++m)
#pragma unroll
                for (int n = 0; n < 2; ++n) acc[a][b][m][n] = (f32x4){0.f, 0.f, 0.f, 0.f};
    }
    bf16x8 At[4][2], B0[2][2], B1[2][2];
    const char* cA = (const char*)g.A + (size_t)cur.pm * tstep; const char* cB = (const char*)g.Bt + (size_t)cur.pn * tstep;
    S.a_ready(cur);
    if constexpr (SP2) {
        PG8_STAGE(PG8_SB(0, 0), cB, voffB); PG8_STAGE(PG8_SB(0, 1), cB + hstep, voffB); PG8_STAGE(PG8_SA(0, 0), cA, voffA); PG8_STAGE(PG8_SA(0, 1), cA + hstep, voffA);
        if (wr == 1) PG8_BAR;
        PG8_WAIT_V(2); PG8_BAR;
        PG8_STAGE(PG8_SB(1, 0), cB + kstep, voffB); PG8_STAGE(PG8_SA(1, 0), cA + kstep, voffA); PG8_STAGE(PG8_SB(1, 1), cB + hstep + kstep, voffB);
        if constexpr (Epi::HAS_PRE) E.pre(S);
        PG8_WAIT_V(6); PG8_BAR;
    } else {
        PG8_STAGE(PG8_SB(0, 0), cB, voffB); PG8_STAGE(PG8_SA(0, 0), cA, voffA); PG8_STAGE(PG8_SB(0, 1), cB + hstep, voffB); PG8_STAGE(PG8_SA(0, 1), cA + hstep, voffA);
        if (wr == 1) PG8_BAR;
        PG8_WAIT_V(4); PG8_BAR;
        PG8_STAGE(PG8_SB(1, 0), cB + kstep, voffB); PG8_STAGE(PG8_SA(1, 0), cA + kstep, voffA); PG8_STAGE(PG8_SB(1, 1), cB + hstep + kstep, voffB);
        PG8_WAIT_V(6); PG8_BAR;
    }
    if constexpr (Epi::INIT_ACC) { PG8_SCHED; E.unpack_init(acc, raw_init); PG8_SCHED; }
    for (;;) {
        const bool has_next = S.next(ui + 1, nxt);
        const char* nA = has_next ? (const char*)g.A + (size_t)nxt.pm * tstep : cA; const char* nB = has_next ? (const char*)g.Bt + (size_t)nxt.pn * tstep : cB;
        for (int t = 0; t < nt; t += 2) {
            const bool last = (t == nt - 2);
            const char* a1 = cA + (size_t)(t + 1) * kstep;
            const char* a2 = last ? nA : cA + (size_t)(t + 2) * kstep; const char* b2 = last ? nB : cB + (size_t)(t + 2) * kstep;
            const char* a3 = a2 + kstep; const char* b3 = b2 + kstep;
            if (last && has_next) S.a_ready(nxt);
            if constexpr (SP2) {
            PG8_LDB(B0, 0, 0); PG8_LDB(B1, 0, 1); PG8_SCHED; PG8_LDA(At, 0, 0); PG8_STAGE(PG8_SA(1, 1), a1 + hstep, voffA);
            PG8_WAIT_V(8); PG8_WAIT_L(0); PG8_BAR; PG8_MMA(0, 0, At, B0); PG8_MMA(0, 1, At, B1); PG8_BAR; PG8_SCHED;
            PG8_LDA(At, 0, 1); PG8_STAGE(PG8_SB(0, 0), b2, voffB); PG8_STAGE(PG8_SB(0, 1), b2 + hstep, voffB); PG8_STAGE(PG8_SA(0, 0), a2, voffA);
            PG8_WAIT_V(8); PG8_WAIT_L(0); PG8_BAR; PG8_MMA(1, 0, At, B0); PG8_MMA(1, 1, At, B1); PG8_BAR; PG8_SCHED;
            PG8_LDB(B0, 1, 0); PG8_LDB(B1, 1, 1); PG8_SCHED; PG8_LDA(At, 1, 0); PG8_STAGE(PG8_SA(0, 1), a2 + hstep, voffA);
            PG8_WAIT_V(8); PG8_WAIT_L(0); PG8_BAR; PG8_MMA(0, 0, At, B0); PG8_MMA(0, 1, At, B1); PG8_BAR; PG8_SCHED;
            PG8_LDA(At, 1, 1); PG8_STAGE(PG8_SB(1, 0), b3, voffB); PG8_STAGE(PG8_SB(1, 1), b3 + hstep, voffB); PG8_STAGE(PG8_SA(1, 0), a3, voffA);
            PG8_WAIT_V(8); PG8_WAIT_L(0); PG8_BAR; PG8_MMA(1, 0, At, B0); PG8_MMA(1, 1, At, B1); PG8_BAR; PG8_SCHED;
            } else {
            PG8_LDB(B0, 0, 0); PG8_SCHED; PG8_LDA(At, 0, 0); PG8_STAGE(PG8_SA(1, 1), a1 + hstep, voffA);
            PG8_WAIT_L(8); PG8_BAR; PG8_WAIT_L(0); PG8_MMA(0, 0, At, B0); PG8_BAR; PG8_SCHED;
            PG8_LDB(B1, 0, 1); PG8_STAGE(PG8_SB(0, 0), b2, voffB);
            PG8_BAR; PG8_WAIT_L(0); PG8_MMA(0, 1, At, B1); PG8_BAR;
            PG8_LDA(At, 0, 1); PG8_STAGE(PG8_SA(0, 0), a2, voffA);
            PG8_BAR; PG8_WAIT_L(0); PG8_MMA(1, 0, At, B0); PG8_BAR; PG8_SCHED;
            PG8_STAGE(PG8_SB(0, 1), b2 + hstep, voffB);
            PG8_WAIT_V(6); PG8_BAR; PG8_MMA(1, 1, At, B1); PG8_BAR;
            PG8_LDB(B0, 1, 0); PG8_SCHED; PG8_LDA(At, 1, 0); PG8_STAGE(PG8_SA(0, 1), a2 + hstep, voffA);
            PG8_WAIT_L(8); PG8_BAR; PG8_WAIT_L(0); PG8_MMA(0, 0, At, B0); PG8_BAR; PG8_SCHED;
            PG8_LDB(B1, 1, 1); PG8_STAGE(PG8_SB(1, 0), b3, voffB);
            PG8_BAR; PG8_WAIT_L(0); PG8_MMA(0, 1, At, B1); PG8_BAR;
            PG8_LDA(At, 1, 1); PG8_STAGE(PG8_SA(1, 0), a3, voffA);
            PG8_BAR; PG8_WAIT_L(0); PG8_MMA(1, 0, At, B0); PG8_BAR; PG8_SCHED;
            PG8_STAGE(PG8_SB(1, 1), b3 + hstep, voffB);
            PG8_WAIT_V(6); PG8_BAR; PG8_MMA(1, 1, At, B1); PG8_BAR;
            }
        }
        if constexpr (ALIGN_EPI) { if (wr == 0) PG8_BAR; }
        if constexpr (!Epi::AFTER_DRAIN) { E(acc, cur, wr, wc, fr, fq); S.done(cur); }
        if (!has_next) break;
        if constexpr (Epi::INIT_ACC) { E.load_init(raw_init, nxt, wr, wc, fr, fq); E.unpack_init(acc, raw_init); }
        else {
#pragma unroll
        for (int a = 0; a < 2; ++a)
#pragma unroll
            for (int b = 0; b < 2; ++b)
#pragma unroll
                for (int m = 0; m < 4; ++m)
#pragma unroll
                    for (int n = 0; n < 2; ++n) acc[a][b][m][n] = (f32x4){0.f, 0.f, 0.f, 0.f};
        }
        cur = nxt; cA = nA; cB = nB; ++ui;
        if constexpr (ALIGN_EPI) { if (wr == 1) PG8_BAR; }
    }
    PG8_WAIT_V(0);
    if constexpr (!ALIGN_EPI) { if (wr == 0) PG8_BAR; }
    PG8_BAR;
    if constexpr (Epi::AFTER_DRAIN) { E.fused(acc, cur, wr, wc, fr, fq, lds, wid, lane); S.done(cur); }
#undef PG8_SA
#undef PG8_SB
#undef PG8_STAGE
#undef PG8_LDA
#undef PG8_LDB
#undef PG8_MMA
#undef PG8_WAIT_V
#undef PG8_WAIT_L
#undef PG8_BAR
#undef PG8_SCHED
}
}
#define XB_TMO      128
#define XB_XCNT(j)  (256  + 64 * (j))
#define XB_XSUB(j)  (1280 + 64 * (j))
#define XB_XGEN(j)  (2304 + 64 * (j))
#define XB_TOP      3328
#define XB_TOPGEN   3392
#define XCD_BAR_WORDS 3456
#define XB_SPIN_CAP (1u << 18)

__device__ __forceinline__ unsigned xb_ld(unsigned* p)              { return __hip_atomic_load(p, __ATOMIC_RELAXED, __HIP_MEMORY_SCOPE_AGENT); }
__device__ __forceinline__ unsigned xb_add(unsigned* p, unsigned v) { return __hip_atomic_fetch_add(p, v, __ATOMIC_RELAXED, __HIP_MEMORY_SCOPE_AGENT); }
__device__ __forceinline__ unsigned xb_xcc_id() { return (unsigned)__builtin_amdgcn_s_getreg((3 << 11) | 20) & 0xFu; }
#define XB_SPIN(cond, bar) do { unsigned _sp = 0; while (cond) { __builtin_amdgcn_s_sleep(1); \
    if ((++_sp & 255u) == 0u) { if (xb_ld(&(bar)[XB_TMO])) break; if (_sp > XB_SPIN_CAP) { atomicAdd(&(bar)[XB_TMO], 1u); break; } } } } while (0)

struct XcdBarrier {
    unsigned* bar; unsigned x;
    volatile PG8_LAS unsigned* st;
};

__device__ __forceinline__ XcdBarrier xcd_barrier_post(unsigned* bar, volatile PG8_LAS unsigned* st) {
    XcdBarrier b; b.bar = bar; b.x = xb_xcc_id(); b.st = st;
    if (threadIdx.x == 0) (void)xb_add(&bar[XB_XCNT(b.x)], 1u);
    return b;
}
__device__ __forceinline__ void xcd_barrier_complete(unsigned* bar, unsigned x, unsigned& nloc, unsigned& nx) {
    const unsigned G = gridDim.x * gridDim.y * gridDim.z;
    unsigned sum, cnt, mine, sp = 0u;
    for (;;) {
        sum = 0u; cnt = 0u; mine = 0u;
#pragma unroll
        for (unsigned j = 0; j < 16; ++j) { const unsigned c = xb_ld(&bar[XB_XCNT(j)]); sum += c; cnt += (c > 0u) ? 1u : 0u; mine = (j == x) ? c : mine; }
        if (sum == G) break;
        __builtin_amdgcn_s_sleep(1);
        if ((++sp & 255u) == 0u) { if (xb_ld(&bar[XB_TMO])) break; if (sp > XB_SPIN_CAP) { atomicAdd(&bar[XB_TMO], 1u); break; } }
    }
    nloc = mine > 0u ? mine : 1u; nx = cnt > 0u ? cnt : 1u;
}

__device__ __forceinline__ void xcd_barrier(const XcdBarrier& b) {
    asm volatile("s_waitcnt vmcnt(0)" ::: "memory");
    __syncthreads();
    if (threadIdx.x == 0) {
        unsigned* bar = b.bar;
        __builtin_amdgcn_s_waitcnt(0);
        unsigned nloc = b.st[0], nx = b.st[1];
        if (nloc == 0u) { xcd_barrier_complete(bar, b.x, nloc, nx); b.st[0] = nloc; b.st[1] = nx; }
        const unsigned old = xb_add(&bar[XB_XSUB(b.x)], 1u);
        const unsigned gen = old / nloc;
        if (old + 1u == (gen + 1u) * nloc) {
            __builtin_amdgcn_fence(__ATOMIC_RELEASE, "agent");
            asm volatile("s_waitcnt vmcnt(0)" ::: "memory");
            const unsigned og = xb_add(&bar[XB_TOP], 1u);
            const unsigned tg = og / nx;
            if (og + 1u == (tg + 1u) * nx) xb_add(&bar[XB_TOPGEN], 1u);
            else XB_SPIN(xb_ld(&bar[XB_TOPGEN]) == tg, bar);
            __builtin_amdgcn_fence(__ATOMIC_ACQUIRE, "agent");
            xb_add(&bar[XB_XGEN(b.x)], 1u);
            asm volatile("s_waitcnt vmcnt(0)" ::: "memory");
        } else {
            XB_SPIN(xb_ld(&bar[XB_XGEN(b.x)]) == gen, bar);
            __builtin_amdgcn_fence(__ATOMIC_ACQUIRE, "agent");
            asm volatile("s_waitcnt vmcnt(0)" ::: "memory");
        }
    }
    __syncthreads();
}
using pg8::bf16_t; using pg8::bf16x8; using pg8::f32x4; using pg8::u32x4; using pg8::cvt_pk_bf16;
#define LAS PG8_LAS
typedef unsigned u32x2 __attribute__((ext_vector_type(2)));
typedef float f32x2 __attribute__((ext_vector_type(2)));

constexpr int SEQ = 16384, DM = 1024, DEPTH = 4, PIN = 2576, PN = 2816, DFF = 2816, DLRU = 512, NCH = 256, CHUNK = 64;
constexpr int C_LG = 512, C_Q = 1024, C_K = 1280, C_V = 1536, C_G = 2048, C_Z = 2560;
constexpr float EPS = 1e-6f;
constexpr size_t al256(size_t x) { return (x + 255) & ~(size_t)255; }
constexpr size_t WS_WIN = 0;
constexpr size_t WS_WOUT = WS_WIN + al256((size_t)DEPTH * PN * DM * 2);
constexpr size_t WS_WF1 = WS_WOUT + al256((size_t)DEPTH * DM * DM * 2);
constexpr size_t WS_WF2 = WS_WF1 + al256((size_t)DEPTH * 2 * DFF * DM * 2);
constexpr size_t WS_WG = WS_WF2 + al256((size_t)DEPTH * DM * DFF * 2);
constexpr size_t WS_XN = WS_WG + al256((size_t)DEPTH * 2 * 8 * 64 * 64 * 2);
constexpr size_t WS_P = WS_XN + al256((size_t)SEQ * DM * 2);
constexpr size_t WS_MIX = WS_P + al256((size_t)SEQ * PN * 2);
constexpr size_t WS_U = WS_MIX + al256((size_t)SEQ * DM * 2);
constexpr size_t WS_HL = WS_U + al256((size_t)NCH * 32768 * 4);
constexpr size_t WS_DEC = WS_HL + al256((size_t)SEQ * DLRU * 4);
constexpr size_t WS_PT = WS_DEC + al256((size_t)NCH * 256 * 4);
constexpr size_t WS_HE = WS_PT + al256((size_t)NCH * DLRU * 4);
constexpr size_t WS_SS = WS_HE + al256((size_t)NCH * DLRU * 4);
constexpr size_t WS_BAR = WS_SS + al256((size_t)16 * SEQ * 4);
constexpr size_t WS_SB = WS_BAR + al256((size_t)XCD_BAR_WORDS * 4);
constexpr size_t WS_END = WS_SB + al256((size_t)NCH * 32768 * 2);
constexpr int WAVE_LDS = 18432, LDS_BYTES = 8 * WAVE_LDS;
static_assert(LDS_BYTES >= pg8::STAGE_BYTES, "lds");

struct Params {
    const float* x; const float* norm1; const float* w_in; const float* conv_w; const float* conv_b; const float* lru_wa; const float* lru_ba; const float* lru_wi; const float* lru_bi;
    const float* lru_lambda; const float* gla_w_alpha; const float* gla_b_alpha; const float* gla_norm; const float* w_out; const float* norm2; const float* w_ffn_in; const float* w_ffn_out; const float* final_norm;
    float* out; unsigned char* ws; int ph_lo, ph_hi;
};

__device__ __forceinline__ unsigned f2bf(float f) { unsigned u = __builtin_bit_cast(unsigned, f); return (u + 0x7fffu + ((u >> 16) & 1u)) >> 16; }
__device__ __forceinline__ float bf2f(unsigned short b) { return __builtin_bit_cast(float, ((unsigned)b) << 16); }
__device__ __forceinline__ float bflo(unsigned w) { return __builtin_bit_cast(float, w << 16); }
__device__ __forceinline__ float bfhi(unsigned w) { return __builtin_bit_cast(float, w & 0xffff0000u); }
__device__ __forceinline__ float fast_sigmoid(float x) { return __builtin_amdgcn_rcpf(1.0f + __builtin_amdgcn_exp2f(-1.4426950408889634f * x)); }
__device__ __forceinline__ float silu_f(float x) { return x * fast_sigmoid(x); }
__device__ __forceinline__ float gelu_tanh_f(float x) { const float y = 0.7978845608028654f * (x + 0.044715f * x * x * x); return x * fast_sigmoid(2.0f * y); }
#define MFMA16(a, b, c) __builtin_amdgcn_mfma_f32_16x16x32_bf16(a, b, c, 0, 0, 0)

__device__ __forceinline__ float row_rstd(const float* ssp, int row) {
    const f32x4 a = *(const f32x4*)(ssp + (size_t)row * 16), b = *(const f32x4*)(ssp + (size_t)row * 16 + 4), c = *(const f32x4*)(ssp + (size_t)row * 16 + 8), d = *(const f32x4*)(ssp + (size_t)row * 16 + 12);
    const float s = ((a[0] + a[1]) + (a[2] + a[3])) + ((b[0] + b[1]) + (b[2] + b[3])) + (((c[0] + c[1]) + (c[2] + c[3])) + ((d[0] + d[1]) + (d[2] + d[3])));
    return __builtin_amdgcn_rsqf(s * (1.0f / DM) + EPS); }
constexpr int RST_OFF = pg8::STAGE_BYTES;
template <class Sched> __device__ __forceinline__ void fill_rstd(LAS unsigned char* lds, const Sched& S, const float* ssp) {
    const int tid = opaque_tid(); LAS float* rst = (LAS float*)(lds + RST_OFF);
    for (int i = (tid >> 8); i < 8; i += 2) { pg8::Unit u; if (!S.next(i, u)) break; rst[i * 256 + (tid & 255)] = row_rstd(ssp, u.pm * 256 + (tid & 255)); }
    __syncthreads();
}
struct EpiStoreBf16 {
    static constexpr bool PERM = true, AFTER_DRAIN = false, INIT_ACC = false, HAS_PRE = true;
    bf16_t* O; int ldc; LAS float* rst; const float* ssp;
    template <class Sched> __device__ __forceinline__ void pre(const Sched& S) const {
        const int tid = opaque_tid();
        for (int i = (tid >> 8); i < 8; i += 2) { pg8::Unit u; if (!S.next(i, u)) break; rst[i * 256 + (tid & 255)] = row_rstd(ssp, u.pm * 256 + (tid & 255)); }
    }
    __device__ __forceinline__ void operator()(const f32x4 (&acc)[2][2][4][2], const pg8::Unit& u, int wr, int wc, int fr, int fq) const {
        const int row0 = u.pm * 256 + wr * 64 + fr, col0 = u.pn * 256 + wc * 32 + 8 * fq;
#pragma unroll
        for (int ai = 0; ai < 2; ++ai)
#pragma unroll
            for (int m = 0; m < 4; ++m) { const int row = row0 + ai * 128 + m * 16; const float rs = rst[u.ui * 256 + wr * 64 + fr + ai * 128 + m * 16]; bf16_t* rowp = O + (size_t)row * ldc + col0;
#pragma unroll
                for (int bj = 0; bj < 2; ++bj) { const f32x4 v0 = acc[ai][bj][m][0] * rs, v1 = acc[ai][bj][m][1] * rs;
                    u32x4 w; w.x = cvt_pk_bf16(v0[0], v0[1]); w.y = cvt_pk_bf16(v0[2], v0[3]); w.z = cvt_pk_bf16(v1[0], v1[1]); w.w = cvt_pk_bf16(v1[2], v1[3]);
                    *(u32x4*)(rowp + bj * 128) = w; } }
    }
};
struct EpiSwiglu {
    static constexpr bool PERM = true, AFTER_DRAIN = false, INIT_ACC = false, HAS_PRE = true;
    bf16_t* O; int ldc; LAS float* rst; const float* ssp;
    template <class Sched> __device__ __forceinline__ void pre(const Sched& S) const {
        const int tid = opaque_tid();
        for (int i = (tid >> 8); i < 8; i += 2) { pg8::Unit u; if (!S.next(i, u)) break; rst[i * 256 + (tid & 255)] = row_rstd(ssp, u.pm * 256 + (tid & 255)); }
    }
    __device__ __forceinline__ void operator()(const f32x4 (&acc)[2][2][4][2], const pg8::Unit& u, int wr, int wc, int fr, int fq) const {
        const int row0 = u.pm * 256 + wr * 64 + fr, col0 = u.pn * 128 + wc * 32 + 8 * fq;
#pragma unroll
        for (int ai = 0; ai < 2; ++ai)
#pragma unroll
            for (int m = 0; m < 4; ++m) { const int row = row0 + ai * 128 + m * 16; const float rs = rst[u.ui * 256 + wr * 64 + fr + ai * 128 + m * 16]; bf16_t* rowp = O + (size_t)row * ldc + col0;
                const float rs2 = rs * rs, c1 = -1.4426950408889634f * rs;
                const f32x4 g0 = acc[ai][0][m][0], g1 = acc[ai][0][m][1], u0 = acc[ai][1][m][0], u1 = acc[ai][1][m][1];
                const f32x4 t0 = g0 * c1, t1 = g1 * c1;
                f32x4 d0, d1;
#pragma unroll
                for (int j = 0; j < 4; ++j) { d0[j] = __builtin_amdgcn_exp2f(t0[j]); d1[j] = __builtin_amdgcn_exp2f(t1[j]); }
                d0 = d0 + 1.0f; d1 = d1 + 1.0f;
                f32x4 r0, r1;
#pragma unroll
                for (int j = 0; j < 4; ++j) { r0[j] = __builtin_amdgcn_rcpf(d0[j]); r1[j] = __builtin_amdgcn_rcpf(d1[j]); }
                const f32x4 v0 = ((g0 * u0) * rs2) * r0, v1 = ((g1 * u1) * rs2) * r1;
                u32x4 w; w.x = cvt_pk_bf16(v0[0], v0[1]); w.y = cvt_pk_bf16(v0[2], v0[3]); w.z = cvt_pk_bf16(v1[0], v1[1]); w.w = cvt_pk_bf16(v1[2], v1[3]);
                *(u32x4*)rowp = w; }
    }
};
struct EpiRes {
    static constexpr bool PERM = true, AFTER_DRAIN = false, INIT_ACC = true, HAS_PRE = false;
    bf16_t* xb; float* ss; int ldc;
    __device__ __forceinline__ void load_init(u32x4 (&raw)[2][4][2], const pg8::Unit& u, int wr, int wc, int fr, int fq) const {
        const int row0 = u.pm * 256 + wr * 64 + fr, col0 = u.pn * 256 + wc * 32 + 8 * fq;
#pragma unroll
        for (int ai = 0; ai < 2; ++ai)
#pragma unroll
            for (int m = 0; m < 4; ++m)
#pragma unroll
                for (int bj = 0; bj < 2; ++bj) raw[ai][m][bj] = *(const u32x4*)(xb + (size_t)(row0 + ai * 128 + m * 16) * ldc + col0 + bj * 128);
    }
    __device__ __forceinline__ void unpack_init(f32x4 (&acc)[2][2][4][2], const u32x4 (&raw)[2][4][2]) const {
#pragma unroll
        for (int ai = 0; ai < 2; ++ai)
#pragma unroll
            for (int m = 0; m < 4; ++m)
#pragma unroll
                for (int bj = 0; bj < 2; ++bj) { const u32x4 b = raw[ai][m][bj];
                    acc[ai][bj][m][0] = (f32x4){bflo(b.x), bfhi(b.x), bflo(b.y), bfhi(b.y)}; acc[ai][bj][m][1] = (f32x4){bflo(b.z), bfhi(b.z), bflo(b.w), bfhi(b.w)}; }
    }
    __device__ __forceinline__ void operator()(const f32x4 (&acc)[2][2][4][2], const pg8::Unit& u, int wr, int wc, int fr, int fq) const {
        const int row0 = u.pm * 256 + wr * 64 + fr, col0 = u.pn * 256 + wc * 32 + 8 * fq;
#pragma unroll
        for (int ai = 0; ai < 2; ++ai)
#pragma unroll
            for (int m = 0; m < 4; ++m) { const int row = row0 + ai * 128 + m * 16; const size_t off = (size_t)row * ldc + col0; float s = 0.f;
#pragma unroll
                for (int bj = 0; bj < 2; ++bj) { const f32x4 v0 = acc[ai][bj][m][0], v1 = acc[ai][bj][m][1];
                    u32x4 w; w.x = cvt_pk_bf16(v0[0], v0[1]); w.y = cvt_pk_bf16(v0[2], v0[3]); w.z = cvt_pk_bf16(v1[0], v1[1]); w.w = cvt_pk_bf16(v1[2], v1[3]);
                    *(u32x4*)(xb + off + bj * 128) = w;
                    s += v0[0] * v0[0] + v0[1] * v0[1] + v0[2] * v0[2] + v0[3] * v0[3] + v1[0] * v1[0] + v1[1] * v1[1] + v1[2] * v1[2] + v1[3] * v1[3]; }
                s += __shfl_xor(s, 16); s += __shfl_xor(s, 32);
                if (fq == 0) ss[(size_t)row * 16 + u.pn * 4 + wc] = s; }
    }
};

struct PrepTile { const float* src; const float* gain; bf16_t* dst; int ld, Kd, k0, n0, kind, l; };
__device__ __forceinline__ PrepTile prep_decode(const Params& p, int tix) {
    constexpr int T0 = 160, T1 = 16, T2 = 64, T3 = 352, T4 = 176, TL = T0 + T1 + T2 + T3 + T4;
    PrepTile t; const int l = tix / TL; int r = tix % TL; int kind;
    if (r < T0) kind = 0; else if ((r -= T0) < T1) kind = 1; else if ((r -= T1) < T2) kind = 2; else if ((r -= T2) < T3) kind = 3; else { r -= T3; kind = 4; }
    t.kind = kind; t.l = l; t.Kd = (kind == 4) ? DFF : DM; const int nkt = t.Kd / 64; t.k0 = (r % nkt) * 64; const int nt = r / nkt; t.n0 = nt * 256; t.gain = nullptr;
    if (kind == 0) { t.src = p.w_in + (size_t)l * DM * PIN + t.n0; t.ld = PIN; t.gain = p.norm1 + l * DM; t.dst = (bf16_t*)(p.ws + WS_WIN) + (size_t)l * PN * DM; }
    else if (kind == 1) { t.src = p.w_in + (size_t)l * DM * PIN + C_Z; t.ld = PIN; t.gain = p.norm1 + l * DM; t.dst = (bf16_t*)(p.ws + WS_WIN) + (size_t)l * PN * DM; t.n0 = C_Z; }
    else if (kind == 2) { t.src = p.w_out + (size_t)l * DM * DM + t.n0; t.ld = DM; t.dst = (bf16_t*)(p.ws + WS_WOUT) + (size_t)l * DM * DM; }
    else if (kind == 3) { t.src = p.w_ffn_in + (size_t)l * DM * 2 * DFF + 128 * nt; t.ld = 2 * DFF; t.gain = p.norm2 + l * DM; t.dst = (bf16_t*)(p.ws + WS_WF1) + (size_t)l * 2 * DFF * DM; }
    else { t.src = p.w_ffn_out + (size_t)l * DFF * DM + t.n0; t.ld = DM; t.dst = (bf16_t*)(p.ws + WS_WF2) + (size_t)l * DM * DFF; }
    return t;
}
__device__ __forceinline__ void prep_load(const Params& p, const PrepTile& t, int tid, f32x4 (&v)[8]) {
    const int n4 = (tid & 63) * 4, kw = tid >> 6;
    if (t.kind == 1) { const float* wa = p.gla_w_alpha + (size_t)t.l * 16 * 256 + n4;
#pragma unroll
        for (int i = 0; i < 8; ++i) v[i] = (f32x4){0.f, 0.f, 0.f, 0.f};
#pragma unroll
        for (int hf = 0; hf < 2; ++hf) { f32x4 a[8], z[8][2];
#pragma unroll
            for (int rr = 0; rr < 8; ++rr) a[rr] = *(const f32x4*)(wa + (hf * 8 + rr) * 256);
#pragma unroll
            for (int i = 0; i < 8; ++i) { const float* zr = t.src + (size_t)(t.k0 + i * 8 + kw) * t.ld + hf * 8; z[i][0] = *(const f32x4*)zr; z[i][1] = *(const f32x4*)(zr + 4); }
#pragma unroll
            for (int i = 0; i < 8; ++i)
#pragma unroll
                for (int rr = 0; rr < 8; ++rr) v[i] += a[rr] * z[i][rr >> 2][rr & 3]; }
    } else { const int sc = (t.kind == 3 && n4 >= 128) ? (DFF - 128 + n4) : n4;
#pragma unroll
        for (int i = 0; i < 8; ++i) v[i] = *(const f32x4*)(t.src + (size_t)(t.k0 + i * 8 + kw) * t.ld + sc); }
    if (t.gain) {
#pragma unroll
        for (int i = 0; i < 8; ++i) v[i] *= t.gain[t.k0 + i * 8 + kw]; }
}
__device__ __forceinline__ void prep_tiles(const Params& p, LAS unsigned char* lds, const int tile_lo, const int tile_hi, const int rank, const int nranks) {
    LAS float* T = (LAS float*)lds;
    const int tid = opaque_tid();
    int tix = tile_lo + rank; f32x4 v[8]; PrepTile t;
    if (tix < tile_hi) { t = prep_decode(p, tix); prep_load(p, t, tid, v); }
    while (tix < tile_hi) {
        { const int n4 = (tid & 63) * 4, kw = tid >> 6;
#pragma unroll
            for (int i = 0; i < 8; ++i) { LAS float* d = T + (i * 8 + kw) * 257 + n4; d[0] = v[i][0]; d[1] = v[i][1]; d[2] = v[i][2]; d[3] = v[i][3]; } }
        __syncthreads();
        const PrepTile cur = t; tix += nranks;
        if (tix < tile_hi) { t = prep_decode(p, tix); prep_load(p, t, tid, v); }
        { const int kseg = tid & 7;
#pragma unroll
            for (int ps = 0; ps < 4; ++ps) { const int n = ps * 64 + (tid >> 3); const LAS float* s = T + (8 * kseg) * 257 + n;
                u32x4 w; w.x = cvt_pk_bf16(s[0], s[257]); w.y = cvt_pk_bf16(s[2 * 257], s[3 * 257]); w.z = cvt_pk_bf16(s[4 * 257], s[5 * 257]); w.w = cvt_pk_bf16(s[6 * 257], s[7 * 257]);
                *(u32x4*)(cur.dst + (size_t)(cur.n0 + n) * cur.Kd + cur.k0 + 8 * kseg) = w; } }
        __syncthreads();
    }
}
template <class Sched> __device__ __forceinline__ void prep_in_tail(const Params& p, LAS unsigned char* lds, const Sched& S, const int tile_lo, const int tile_hi) {
    const int rem = S.nwg % S.G;
    if (rem == 0) prep_tiles(p, lds, tile_lo, tile_hi, S.c, S.G);
    else if (S.c >= rem) prep_tiles(p, lds, tile_lo, tile_hi, S.c - rem, S.G - rem);
}
__device__ __forceinline__ void prep_gates(const Params& p) {
    const int tid = opaque_tid();
    bf16_t* wg = (bf16_t*)(p.ws + WS_WG);
    for (int idx = blockIdx.x * 512 + tid; idx < DEPTH * 2 * 8 * 4096; idx += gridDim.x * 512) {
        const int i = idx & 63, j = (idx >> 6) & 63, blk = (idx >> 12) & 7, g = (idx >> 15) & 1, l = idx >> 16;
        const float* s = (g ? p.lru_wi : p.lru_wa) + (size_t)l * 8 * 4096 + blk * 4096 + i * 64 + j;
        wg[idx] = (bf16_t)f2bf(-1.4426950408889634f * *s);
    }
}

__device__ __forceinline__ void x_to_bf16(const float* X, bf16_t* XB, float* SS0) {
    const int tid = opaque_tid(), lane = tid & 63, gw = blockIdx.x * 8 + (tid >> 6), nw = gridDim.x * 8;
#pragma unroll 2
    for (int r = gw; r < SEQ; r += nw) {
        const float* xr = X + (size_t)r * DM; f32x4 v[4]; float s = 0.f;
#pragma unroll
        for (int i = 0; i < 4; ++i) { v[i] = *(const f32x4*)(xr + i * 256 + lane * 4); s += v[i][0] * v[i][0] + v[i][1] * v[i][1] + v[i][2] * v[i][2] + v[i][3] * v[i][3]; }
#pragma unroll
        for (int o = 32; o >= 1; o >>= 1) s += __shfl_xor(s, o);
        if (lane < 16) SS0[(size_t)r * 16 + lane] = (lane == 0) ? s : 0.f;
#pragma unroll
        for (int i = 0; i < 4; ++i) { u32x2 w; w.x = cvt_pk_bf16(v[i][0], v[i][1]); w.y = cvt_pk_bf16(v[i][2], v[i][3]); *(u32x2*)(XB + (size_t)r * DM + i * 256 + lane * 4) = w; }
    }
}
__device__ __forceinline__ void final_norm(const bf16_t* XB, float* OUT, const float* ss, const float* gain) {
    const int tid = opaque_tid();
    const bool grouped = gridDim.x == 256;
    const int step = grouped ? 512 * 4 : gridDim.x * 512 * 4, first = grouped ? (2048 * (blockIdx.x & 7) + 64 * (blockIdx.x >> 3)) * 128 : blockIdx.x * 512 * 4, last = grouped ? first + 4 * step : SEQ * DM / 8;
    for (int base = first; base < last; base += step) {
        u32x4 v[4];
#pragma unroll
        for (int i = 0; i < 4; ++i) v[i] = *(const u32x4*)(XB + (size_t)(base + i * 512 + tid) * 8);
#pragma unroll
        for (int i = 0; i < 4; ++i) { const int e = (base + i * 512 + tid) * 8, row = e >> 10, col = e & 1023; const float rs = row_rstd(ss, row);
            const f32x4 g0 = *(const f32x4*)(gain + col), g1 = *(const f32x4*)(gain + col + 4);
            *(f32x4*)(OUT + (size_t)e) = (f32x4){bflo(v[i].x), bfhi(v[i].x), bflo(v[i].y), bfhi(v[i].y)} * rs * g0;
            *(f32x4*)(OUT + (size_t)e + 4) = (f32x4){bflo(v[i].z), bfhi(v[i].z), bflo(v[i].w), bfhi(v[i].w)} * rs * g1; }
    }
}
#define WAVE_SYNC() do { asm volatile("s_waitcnt lgkmcnt(0)" ::: "memory"); __builtin_amdgcn_wave_barrier(); asm volatile("" ::: "memory"); } while (0)
__device__ __forceinline__ bf16x8 pack8(const float (&v)[8]) { u32x4 w; w.x = cvt_pk_bf16(v[0], v[1]); w.y = cvt_pk_bf16(v[2], v[3]); w.z = cvt_pk_bf16(v[4], v[5]); w.w = cvt_pk_bf16(v[6], v[7]); return __builtin_bit_cast(bf16x8, w); }

__device__ __forceinline__ void mixer_a(const Params& p, const int l, LAS unsigned char* lds) {
    const int tid = opaque_tid(), lane = tid & 63, w = __builtin_amdgcn_readfirstlane(tid >> 6), c = lane & 15, q = lane >> 4;
    LAS unsigned char* wl = lds + w * WAVE_LDS;
    LAS bf16_t* xs = (LAS bf16_t*)wl;
    LAS float* sa = (LAS float*)wl;
    LAS float* su = (LAS float*)(wl + 4096);
    LAS bf16_t* xcs = (LAS bf16_t*)(wl + 8704);
    LAS bf16_t* zs = (LAS bf16_t*)wl;
    LAS bf16_t* ks = (LAS bf16_t*)(wl + 8192);
    LAS bf16_t* kdT = (LAS bf16_t*)wl;
    LAS unsigned char* vt = wl + 9216;
    const bf16_t* P = (const bf16_t*)(p.ws + WS_P);
    unsigned* HL = (unsigned*)(p.ws + WS_HL);
    float* U = (float*)(p.ws + WS_U); float* DEC = (float*)(p.ws + WS_DEC); float* PT = (float*)(p.ws + WS_PT); float* HE = (float*)(p.ws + WS_HE);
    const int hh = w >> 1, half = w & 1, seg = lane & 7, rsub = lane >> 3;
    for (int ch0 = blockIdx.x; ch0 < NCH; ch0 += gridDim.x) { const int ch = (gridDim.x == 256) ? 32 * (ch0 & 7) + (ch0 >> 3) : ch0;
        const int t0 = ch * CHUNK;
        {   u32x4 xv[9];
#pragma unroll
            for (int it = 0; it < 9; ++it) { const int row = it * 8 + rsub, t = t0 - 3 + row; xv[it] = (u32x4){0u, 0u, 0u, 0u};
                if (row < 67 && t >= 0) xv[it] = *(const u32x4*)(P + (size_t)t * PN + 64 * w + 8 * seg); }
            const int gch = 64 * w + 8 * seg; f32x4 cwv[4][2], cbv[2];
#pragma unroll
            for (int j = 0; j < 4; ++j) { cwv[j][0] = *(const f32x4*)(p.conv_w + (size_t)(l * 4 + j) * DLRU + gch); cwv[j][1] = *(const f32x4*)(p.conv_w + (size_t)(l * 4 + j) * DLRU + gch + 4); }
            cbv[0] = *(const f32x4*)(p.conv_b + l * DLRU + gch); cbv[1] = *(const f32x4*)(p.conv_b + l * DLRU + gch + 4);
#pragma unroll
            for (int it = 0; it < 9; ++it) { const int row = it * 8 + rsub; if (row < 67) *(LAS u32x4*)(xs + row * 64 + 8 * seg) = xv[it]; }
            WAVE_SYNC();
#pragma unroll 1
            for (int i = 0; i < 8; ++i) { const int t = i * 8 + rsub; float xc[8];
#pragma unroll
                for (int e = 0; e < 4; ++e) { xc[e] = cbv[0][e]; xc[4 + e] = cbv[1][e]; }
#pragma unroll
                for (int j = 0; j < 4; ++j) { const u32x4 x4 = *(const LAS u32x4*)(xs + (t + j) * 64 + 8 * seg);
                    xc[0] += cwv[j][0][0] * bflo(x4.x); xc[1] += cwv[j][0][1] * bfhi(x4.x); xc[2] += cwv[j][0][2] * bflo(x4.y); xc[3] += cwv[j][0][3] * bfhi(x4.y);
                    xc[4] += cwv[j][1][0] * bflo(x4.z); xc[5] += cwv[j][1][1] * bfhi(x4.z); xc[6] += cwv[j][1][2] * bflo(x4.w); xc[7] += cwv[j][1][3] * bfhi(x4.w); }
                *(LAS bf16x8*)(xcs + t * 64 + 8 * seg) = pack8(xc); }
            WAVE_SYNC();
        }
        const bf16_t* wg = (const bf16_t*)(p.ws + WS_WG) + (size_t)((l * 2) * 8 + w) * 4096;
        bf16x8 Bw[2][4][2];
#pragma unroll
        for (int g = 0; g < 2; ++g)
#pragma unroll
            for (int nt = 0; nt < 4; ++nt)
#pragma unroll
                for (int k2 = 0; k2 < 2; ++k2) Bw[g][nt][k2] = *(const bf16x8*)(wg + (size_t)g * 8 * 4096 + (16 * nt + c) * 64 + 32 * k2 + 8 * q);
        float ba[4], bi[4], sp[4];
#pragma unroll
        for (int nt = 0; nt < 4; ++nt) { const int gch = 64 * w + 16 * nt + c; ba[nt] = -1.4426950408889634f * p.lru_ba[l * DLRU + gch]; bi[nt] = -1.4426950408889634f * p.lru_bi[l * DLRU + gch]; sp[nt] = -8.0f * 1.4426950408889634f * __logf(1.0f + __expf(-p.lru_lambda[l * DLRU + gch])); }
        float hst = 0.f, cp = 1.f;
#pragma unroll 1
        for (int mt = 0; mt < 4; ++mt) {
            const bf16x8 Af0 = *(const LAS bf16x8*)(xcs + (16 * mt + c) * 64 + 8 * q), Af1 = *(const LAS bf16x8*)(xcs + (16 * mt + c) * 64 + 32 + 8 * q);
#pragma unroll
            for (int nt = 0; nt < 4; ++nt) { const int chl = 16 * nt + c;
                f32x4 racc = {ba[nt], ba[nt], ba[nt], ba[nt]}, iacc = {bi[nt], bi[nt], bi[nt], bi[nt]};
                racc = MFMA16(Af0, Bw[0][nt][0], racc); racc = MFMA16(Af1, Bw[0][nt][1], racc); iacc = MFMA16(Af0, Bw[1][nt][0], iacc); iacc = MFMA16(Af1, Bw[1][nt][1], iacc);
#pragma unroll
                for (int reg = 0; reg < 4; ++reg) {
                    const float xc = bf2f(xcs[(16 * mt + 4 * q + reg) * 64 + chl]);
                    const float r = __builtin_amdgcn_rcpf(1.0f + __builtin_amdgcn_exp2f(racc[reg])), ig = __builtin_amdgcn_rcpf(1.0f + __builtin_amdgcn_exp2f(iacc[reg]));
                    const float a = __builtin_amdgcn_exp2f(sp[nt] * r);
                    const float om = __builtin_fmaf(-a, a, 1.0f);
                    sa[(4 * q + reg) * 64 + chl] = a; su[(4 * q + reg) * 64 + chl] = __builtin_amdgcn_sqrtf(om) * ig * xc; } }
            WAVE_SYNC();
            unsigned* hl = HL + (size_t)(t0 + 16 * mt) * DLRU + 64 * w + lane;
#pragma unroll
            for (int tt = 0; tt < 16; ++tt) { const float a = sa[tt * 64 + lane], u = su[tt * 64 + lane]; hst = a * hst + u; cp *= a; hl[(size_t)tt * DLRU] = cvt_pk_bf16(hst, cp); }
            WAVE_SYNC();
        }
        PT[ch * DLRU + 64 * w + lane] = cp; HE[ch * DLRU + 64 * w + lane] = hst;
        WAVE_SYNC();
        {   const int gc = 64 * hh + lane; const float zb = p.gla_b_alpha[l * 256 + gc];
            u32x4 zv[8], kv[8], vv[8];
#pragma unroll
            for (int it = 0; it < 8; ++it) { const bf16_t* row = P + (size_t)(t0 + it * 8 + rsub) * PN;
                zv[it] = *(const u32x4*)(row + C_Z + 64 * hh + 8 * seg); kv[it] = *(const u32x4*)(row + C_K + 64 * hh + 8 * seg); vv[it] = *(const u32x4*)(row + C_V + 128 * hh + 64 * half + 8 * seg); }
#pragma unroll
            for (int it = 0; it < 8; ++it) { *(LAS u32x4*)(zs + (it * 8 + rsub) * 64 + 8 * seg) = zv[it]; *(LAS u32x4*)(ks + (it * 8 + rsub) * 64 + 8 * seg) = kv[it]; }
            WAVE_SYNC();
            bf16x8 kdp[8]; float suf = 0.f;
#pragma unroll
            for (int t8 = 7; t8 >= 0; --t8) { float kd[8];
#pragma unroll
                for (int e = 7; e >= 0; --e) { const int t = 8 * t8 + e;
                    const float z = bf2f(zs[t * 64 + lane]) + zb, kk = bf2f(ks[t * 64 + lane]);
                    const float la = (fminf(z, 0.f) - __logf(1.0f + __expf(-fabsf(z)))) * 0.0625f;
                    kd[e] = kk * __expf(suf); suf += la; }
                kdp[t8] = pack8(kd); }
            if (half == 0) DEC[ch * 256 + gc] = __expf(suf);
            WAVE_SYNC();
#pragma unroll
            for (int t8 = 0; t8 < 8; ++t8) *(LAS bf16x8*)(kdT + lane * 72 + 8 * t8) = kdp[t8];
#pragma unroll
            for (int it = 0; it < 8; ++it) { LAS unsigned char* dst = vt + (it * 8 + rsub) * 136 + 16 * seg; *(LAS u32x2*)dst = (u32x2){vv[it].x, vv[it].y}; *(LAS u32x2*)(dst + 8) = (u32x2){vv[it].z, vv[it].w}; }
            WAVE_SYNC();
        }
        {   bf16x8 Ak[4][2];
#pragma unroll
            for (int mt = 0; mt < 4; ++mt)
#pragma unroll
                for (int k2 = 0; k2 < 2; ++k2) Ak[mt][k2] = *(const LAS bf16x8*)(kdT + (16 * mt + c) * 72 + 32 * k2 + 8 * q);
            float* Uc = U + (size_t)(ch * 4 + hh) * 64 * 128;
#pragma unroll
            for (int nt = 0; nt < 4; ++nt) { const int vl = 16 * nt + c, vcol = 64 * half + vl; bf16x8 Bv[2];
#pragma unroll
                for (int k2 = 0; k2 < 2; ++k2) { unsigned short tmp[8];
#pragma unroll
                    for (int e = 0; e < 8; ++e) tmp[e] = *(const LAS unsigned short*)(vt + (32 * k2 + 8 * q + e) * 136 + 2 * vl);
                    u32x4 wv; wv.x = tmp[0] | ((unsigned)tmp[1] << 16); wv.y = tmp[2] | ((unsigned)tmp[3] << 16); wv.z = tmp[4] | ((unsigned)tmp[5] << 16); wv.w = tmp[6] | ((unsigned)tmp[7] << 16);
                    Bv[k2] = __builtin_bit_cast(bf16x8, wv); }
#pragma unroll
                for (int mt = 0; mt < 4; ++mt) { f32x4 acc = {0.f, 0.f, 0.f, 0.f}; acc = MFMA16(Ak[mt][0], Bv[0], acc); acc = MFMA16(Ak[mt][1], Bv[1], acc);
                    *(f32x4*)(Uc + (size_t)vcol * 64 + 16 * mt + 4 * q) = acc; } } }
        __syncthreads();
    }
}

__device__ __forceinline__ void scan_phase(const Params& p, LAS unsigned char* lds) {
    LAS float* sx = (LAS float*)lds; LAS float* sd = sx + 512;
    const int tid = opaque_tid(), i = tid & 127, seg = tid >> 7;
    float* U = (float*)(p.ws + WS_U); const float* DEC = (const float*)(p.ws + WS_DEC); const float* PT = (const float*)(p.ws + WS_PT); float* HE = (float*)(p.ws + WS_HE);
    for (int vb = blockIdx.x; vb < 260; vb += gridDim.x) {
        const float* Dp; float* Up; size_t ds, us;
        if (vb < 256) { const int e = vb * 128 + i; Dp = DEC + ((e >> 13) << 6) + (e & 63); ds = 256; Up = U + e; us = 32768; }
        else { const int chn = (vb - 256) * 128 + i; Dp = PT + chn; ds = 512; Up = HE + chn; us = 512; }
        Dp += (size_t)seg * 64 * ds; Up += (size_t)seg * 64 * us;
        float d[64], u[64];
        { const float* dq = Dp; const float* uq = Up;
#pragma unroll
            for (int j = 0; j < 64; ++j) { d[j] = *dq; u[j] = *uq; dq += ds; uq += us; asm volatile("" : "+v"(dq), "+v"(uq)); } }
        float x = 0.f, dp = 1.f;
#pragma unroll
        for (int j = 0; j < 64; ++j) { x = d[j] * x + u[j]; dp *= d[j]; }
        sx[seg * 128 + i] = x; sd[seg * 128 + i] = dp;
        __syncthreads();
        float carry = 0.f;
        for (int s2 = 0; s2 < seg; ++s2) carry = sd[s2 * 128 + i] * carry + sx[s2 * 128 + i];
        x = carry;
        if (vb < 256) { bf16_t* sq = (bf16_t*)(p.ws + WS_SB) + (size_t)seg * 64 * 32768 + vb * 128 + i;
#pragma unroll
            for (int j = 0; j < 64; ++j) { x = d[j] * x + u[j]; *sq = (bf16_t)f2bf(x); sq += 32768; asm volatile("" : "+v"(sq)); } }
        else { float* uq = Up;
#pragma unroll
            for (int j = 0; j < 64; ++j) { x = d[j] * x + u[j]; *uq = x; uq += us; asm volatile("" : "+v"(uq)); } }
        __syncthreads();
    }
}

__device__ __forceinline__ void mixer_b(const Params& p, const int l, LAS unsigned char* lds) {
    const int tid = opaque_tid(), lane = tid & 63, w = __builtin_amdgcn_readfirstlane(tid >> 6), c = lane & 15, q = lane >> 4;
    LAS float* red = (LAS float*)lds;
    const bf16_t* P = (const bf16_t*)(p.ws + WS_P); bf16_t* MIX = (bf16_t*)(p.ws + WS_MIX);
    const unsigned* HL = (const unsigned*)(p.ws + WS_HL); const float* U = (const float*)(p.ws + WS_U); const float* HE = (const float*)(p.ws + WS_HE);
    const int hh = w >> 1, half = w & 1;
    for (int ch0 = blockIdx.x; ch0 < NCH; ch0 += gridDim.x) { const int ch = (gridDim.x == 256) ? 32 * (ch0 & 7) + (ch0 >> 3) : ch0;
        const int t0 = ch * CHUNK;
#define LRU_LOAD(it0_, h0_, h1_, g4_) do { _Pragma("unroll") for (int j = 0; j < 4; ++j) { const int idx = ((it0_) + j) * 512 + tid, t = idx >> 6; const size_t tok = (size_t)(t0 + t); \
            h0_[j] = *(const u32x4*)(HL + tok * DLRU + lc8); h1_[j] = *(const u32x4*)(HL + tok * DLRU + lc8 + 4); g4_[j] = *(const u32x4*)(P + tok * PN + C_LG + lc8); } } while (0)
#define LRU_COMP(it0_, h0_, h1_, g4_) do { _Pragma("unroll") for (int j = 0; j < 4; ++j) { const int idx = ((it0_) + j) * 512 + tid, t = idx >> 6; const size_t tok = (size_t)(t0 + t); float o[8]; \
            o[0] = (bflo(h0_[j].x) + bfhi(h0_[j].x) * ci0[0]) * gelu_tanh_f(bflo(g4_[j].x)); o[1] = (bflo(h0_[j].y) + bfhi(h0_[j].y) * ci0[1]) * gelu_tanh_f(bfhi(g4_[j].x)); \
            o[2] = (bflo(h0_[j].z) + bfhi(h0_[j].z) * ci0[2]) * gelu_tanh_f(bflo(g4_[j].y)); o[3] = (bflo(h0_[j].w) + bfhi(h0_[j].w) * ci0[3]) * gelu_tanh_f(bfhi(g4_[j].y)); \
            o[4] = (bflo(h1_[j].x) + bfhi(h1_[j].x) * ci1[0]) * gelu_tanh_f(bflo(g4_[j].z)); o[5] = (bflo(h1_[j].y) + bfhi(h1_[j].y) * ci1[1]) * gelu_tanh_f(bfhi(g4_[j].z)); \
            o[6] = (bflo(h1_[j].z) + bfhi(h1_[j].z) * ci1[2]) * gelu_tanh_f(bflo(g4_[j].w)); o[7] = (bflo(h1_[j].w) + bfhi(h1_[j].w) * ci1[3]) * gelu_tanh_f(bfhi(g4_[j].w)); \
            *(bf16x8*)(MIX + tok * DM + lc8) = pack8(o); } } while (0)
        const int lc8 = (tid & 63) * 8;
        f32x4 ci0 = {0.f, 0.f, 0.f, 0.f}, ci1 = {0.f, 0.f, 0.f, 0.f};
        if (ch > 0) { ci0 = *(const f32x4*)(HE + (size_t)(ch - 1) * DLRU + lc8); ci1 = *(const f32x4*)(HE + (size_t)(ch - 1) * DLRU + lc8 + 4); }
        u32x4 h0a[4], h1a[4], g4a[4];
        LRU_LOAD(0, h0a, h1a, g4a);
        const bf16_t* ST = (const bf16_t*)(p.ws + WS_SB) + (size_t)(ch * 4 + hh) * 8192 + (size_t)(64 * half + c) * 64 + 8 * q;
        bf16x8 As[4][2];
#pragma unroll
        for (int mt = 0; mt < 4; ++mt)
#pragma unroll
            for (int k2 = 0; k2 < 2; ++k2) As[mt][k2] = *(const bf16x8*)(ST + (size_t)(16 * mt) * 64 + 32 * k2);
        bf16x8 Bq[4][2];
#pragma unroll
        for (int nt = 0; nt < 4; ++nt)
#pragma unroll
            for (int k2 = 0; k2 < 2; ++k2) Bq[nt][k2] = *(const bf16x8*)(P + (size_t)(t0 + 16 * nt + c) * PN + C_Q + 64 * hh + 32 * k2 + 8 * q);
        f32x4 acc[4][4];
#pragma unroll
        for (int mt = 0; mt < 4; ++mt) { const bf16x8 As0 = As[mt][0], As1 = As[mt][1];
#pragma unroll
            for (int nt = 0; nt < 4; ++nt) { f32x4 a = {0.f, 0.f, 0.f, 0.f}; a = MFMA16(As0, Bq[nt][0], a); a = MFMA16(As1, Bq[nt][1], a); acc[mt][nt] = a * 0.125f; } }
        u32x2 gv[4][4];
#pragma unroll
        for (int mt = 0; mt < 4; ++mt)
#pragma unroll
            for (int nt = 0; nt < 4; ++nt) gv[mt][nt] = *(const u32x2*)(P + (size_t)(t0 + 16 * nt + c) * PN + C_G + 128 * hh + 64 * half + 16 * mt + 4 * q);
        float rstd[4];
#pragma unroll
        for (int nt = 0; nt < 4; ++nt) { float s = 0.f;
#pragma unroll
            for (int mt = 0; mt < 4; ++mt) { const f32x4 a = acc[mt][nt]; s += a[0] * a[0] + a[1] * a[1] + a[2] * a[2] + a[3] * a[3]; }
            s += __shfl_xor(s, 16); s += __shfl_xor(s, 32);
            if (q == 0) red[w * 64 + 16 * nt + c] = s; }
        __syncthreads();
#pragma unroll
        for (int nt = 0; nt < 4; ++nt) rstd[nt] = __builtin_amdgcn_rsqf((red[w * 64 + 16 * nt + c] + red[(w ^ 1) * 64 + 16 * nt + c]) * (1.0f / 128.0f) + EPS);
#pragma unroll
        for (int mt = 0; mt < 4; ++mt) { const int v0 = 64 * half + 16 * mt + 4 * q; const f32x4 gn = *(const f32x4*)(p.gla_norm + l * 128 + v0);
#pragma unroll
            for (int nt = 0; nt < 4; ++nt) { const size_t tok = (size_t)(t0 + 16 * nt + c);
                const f32x4 a = acc[mt][nt]; const float rs = rstd[nt]; const u32x2 g2 = gv[mt][nt];
                const float o0 = a[0] * rs * gn[0] * silu_f(bflo(g2.x)), o1 = a[1] * rs * gn[1] * silu_f(bfhi(g2.x)), o2 = a[2] * rs * gn[2] * silu_f(bflo(g2.y)), o3 = a[3] * rs * gn[3] * silu_f(bfhi(g2.y));
                u32x2 ov; ov.x = cvt_pk_bf16(o0, o1); ov.y = cvt_pk_bf16(o2, o3);
                *(u32x2*)(MIX + tok * DM + 512 + 128 * hh + v0) = ov; } }
        u32x4 h0b[4], h1b[4], g4b[4];
        LRU_LOAD(4, h0b, h1b, g4b);
        LRU_COMP(0, h0a, h1a, g4a);
        LRU_COMP(4, h0b, h1b, g4b);
        __syncthreads();
    }
}
#ifndef EN
#define EN 0xFFFF
#endif
constexpr int LDS_TOTAL = LDS_BYTES + 16;
#ifndef USE_CG
#define USE_CG 0
#endif
#ifndef INK_DUP
#define INK_DUP 0
#endif
#ifndef DUP_MASK
#define DUP_MASK 0
#endif
__device__ __forceinline__ void group_barrier(unsigned* bar, unsigned* cnt) {
    asm volatile("s_waitcnt vmcnt(0)" ::: "memory");
    __syncthreads();
    if (threadIdx.x == 0) {
        __builtin_amdgcn_fence(__ATOMIC_RELEASE, "agent"); asm volatile("s_waitcnt vmcnt(0)" ::: "memory");
        const unsigned old = xb_add(cnt, 1u), target = (old / 32u + 1u) * 32u;
        XB_SPIN(xb_ld(cnt) < target, bar);
        __builtin_amdgcn_fence(__ATOMIC_ACQUIRE, "agent"); asm volatile("s_waitcnt vmcnt(0)" ::: "memory");
    }
    __syncthreads();
}
constexpr int N_PHASES = 1 + 7 * DEPTH + 1;
__global__ void __launch_bounds__(512, 2) fwd_kernel(Params p) {
    extern __shared__ __attribute__((aligned(16))) unsigned char lds_raw[];
    LAS unsigned char* lds = (LAS unsigned char*)lds_raw;
    cg::grid_group grid = cg::this_grid();
    const bool fused = (p.ph_hi - p.ph_lo) > 1;
    volatile LAS unsigned* st = (volatile LAS unsigned*)(lds + LDS_BYTES);
    XcdBarrier bar; bar.bar = (unsigned*)(p.ws + WS_BAR); bar.x = 0; bar.st = st;
    if (fused) { if (threadIdx.x < 4) st[threadIdx.x] = 0u; __syncthreads(); bar = xcd_barrier_post((unsigned*)(p.ws + WS_BAR), st); }
    int ph = 0;
#define RUN(ph_) ((ph_) >= p.ph_lo && (ph_) < p.ph_hi)
#define SEAM(ph_) do { if ((ph_) + 1 < p.ph_hi) { if (USE_CG || p.ph_hi > 4096) grid.sync(); else xcd_barrier(bar); } } while (0)
#define SEAM_G(ph_) do { if ((ph_) + 1 < p.ph_hi) { if (!USE_CG && gridDim.x == 256) group_barrier(bar.bar, bar.bar + 16u * (blockIdx.x & 7u)); else { SEAM(ph_); } } } while (0)
    bf16_t* XB = (bf16_t*)(p.ws + WS_XN); bf16_t* Pb = (bf16_t*)(p.ws + WS_P); bf16_t* MIX = (bf16_t*)(p.ws + WS_MIX); float* SS = (float*)(p.ws + WS_SS);
    if (RUN(ph)) { if (EN & 1) { prep_tiles(p, lds, 0, 768, (int)blockIdx.x, (int)gridDim.x); prep_gates(p); x_to_bf16(p.x, XB, SS); }   SEAM(ph); } ++ph;
#pragma unroll 1
    for (int l = 0; l < DEPTH; ++l) {
        if (RUN(ph)) { pg8::Gemm g{XB, (const bf16_t*)(p.ws + WS_WIN) + (size_t)l * PN * DM, SEQ, PN, DM}; pg8::StaticOrder S; S.init(SEQ, PN, (int)gridDim.x, (int)blockIdx.x);
            EpiStoreBf16 E{Pb, PN, (LAS float*)(lds + RST_OFF), SS}; if (EN & 32) pg8::gemm_phase<EpiStoreBf16, pg8::StaticOrder, true, true>(lds, g, S, E);
            if (l + 1 < DEPTH) prep_in_tail(p, lds, S, (l + 1) * 768, (l + 1) * 768 + 256); SEAM(ph); } ++ph;
        if (RUN(ph)) { if (EN & 4) { mixer_a(p, l, lds); if (INK_DUP & 4) mixer_a(p, l, lds); } SEAM(ph); } ++ph;
        if (RUN(ph)) { if (EN & 8) scan_phase(p, lds); SEAM(ph); } ++ph;
        if (RUN(ph)) { if (EN & 16) { mixer_b(p, l, lds); if (INK_DUP & 16) mixer_b(p, l, lds); } SEAM(ph); } ++ph;
        if (RUN(ph)) { pg8::Gemm g{MIX, (const bf16_t*)(p.ws + WS_WOUT) + (size_t)l * DM * DM, SEQ, DM, DM}; pg8::StaticOrder S; S.init(SEQ, DM, (int)gridDim.x, (int)blockIdx.x);
            EpiRes E{XB, SS, DM}; if (EN & 64) pg8::gemm_phase<EpiRes, pg8::StaticOrder, false, true>(lds, g, S, E); SEAM_G(ph); } ++ph;
        if (RUN(ph)) { pg8::Gemm g{XB, (const bf16_t*)(p.ws + WS_WF1) + (size_t)l * 2 * DFF * DM, SEQ, 2 * DFF, DM}; pg8::StaticOrder S; S.init(SEQ, 2 * DFF, (int)gridDim.x, (int)blockIdx.x);
            EpiSwiglu E{Pb, DFF, (LAS float*)(lds + RST_OFF), SS}; if (EN & 128) pg8::gemm_phase<EpiSwiglu, pg8::StaticOrder, true, true>(lds, g, S, E);
            if (l + 1 < DEPTH) prep_in_tail(p, lds, S, (l + 1) * 768 + 256, (l + 2) * 768); SEAM_G(ph); } ++ph;
        if (RUN(ph)) { pg8::Gemm g{Pb, (const bf16_t*)(p.ws + WS_WF2) + (size_t)l * DM * DFF, SEQ, DM, DFF}; pg8::StaticOrder S; S.init(SEQ, DM, (int)gridDim.x, (int)blockIdx.x);
            EpiRes E{XB, SS, DM}; if (EN & 256) pg8::gemm_phase<EpiRes, pg8::StaticOrder, false, true>(lds, g, S, E); SEAM_G(ph); } ++ph;
    }
    if (RUN(ph)) { final_norm(XB, p.out, SS, p.final_norm); } ++ph;
}

extern "C" void kernel_launch(void* const* d_in, const int* in_sizes, int n_in, void* d_out, int out_size, void* d_ws, size_t ws_size, hipStream_t stream) {
    static int grid = 0;
    if (grid == 0) {
        if (n_in != 18 || in_sizes[0] != SEQ * DM || out_size != SEQ * DM || ws_size < WS_END) { fprintf(stderr, "kernel_launch: unexpected shapes / workspace (n_in %d, ws %zu < %zu)\n", n_in, ws_size, (size_t)WS_END); grid = -1; return; }
        int dev = 0, cus = 0, per_cu = 0;
        hipGetDevice(&dev); hipDeviceGetAttribute(&cus, hipDeviceAttributeMultiprocessorCount, dev);
        if (hipFuncSetAttribute((const void*)fwd_kernel, hipFuncAttributeMaxDynamicSharedMemorySize, LDS_TOTAL) != hipSuccess) { fprintf(stderr, "kernel_launch: hipFuncSetAttribute failed\n"); grid = -1; return; }
        if (hipOccupancyMaxActiveBlocksPerMultiprocessor(&per_cu, (const void*)fwd_kernel, 512, LDS_TOTAL) != hipSuccess || per_cu < 1) { fprintf(stderr, "kernel_launch: occupancy query says %d blocks per CU\n", per_cu); (void)hipGetLastError(); per_cu = 1; }
        grid = cus * 1;
        fprintf(stderr, "kernel_launch: grid %d (cus %d, per_cu %d)\n", grid, cus, per_cu);
    }
    if (grid < 0) return;
    Params p{};
    p.x = (const float*)d_in[0]; p.norm1 = (const float*)d_in[1]; p.w_in = (const float*)d_in[2]; p.conv_w = (const float*)d_in[3]; p.conv_b = (const float*)d_in[4];
    p.lru_wa = (const float*)d_in[5]; p.lru_ba = (const float*)d_in[6]; p.lru_wi = (const float*)d_in[7]; p.lru_bi = (const float*)d_in[8]; p.lru_lambda = (const float*)d_in[9];
    p.gla_w_alpha = (const float*)d_in[10]; p.gla_b_alpha = (const float*)d_in[11]; p.gla_norm = (const float*)d_in[12]; p.w_out = (const float*)d_in[13]; p.norm2 = (const float*)d_in[14];
    p.w_ffn_in = (const float*)d_in[15]; p.w_ffn_out = (const float*)d_in[16]; p.final_norm = (const float*)d_in[17];
    p.out = (float*)d_out; p.ws = (unsigned char*)d_ws;
#if SINGLE_LAUNCH
    p.ph_lo = 0; p.ph_hi = N_PHASES;
    (void)hipMemsetAsync((unsigned char*)d_ws + WS_BAR, 0, (size_t)XCD_BAR_WORDS * 4, stream);
    void* args[] = {&p};
    hipError_t e = hipLaunchCooperativeKernel((const void*)fwd_kernel, dim3(grid), dim3(512), args, LDS_TOTAL, stream);
    if (e != hipSuccess) fprintf(stderr, "cooperative launch failed: %s (grid %d)\n", hipGetErrorString(e), grid);
#else
    for (int i = 0; i < N_PHASES; ++i) { p.ph_lo = i; p.ph_hi = i + 1; const int kind = (i == 0) ? 0 : (i == N_PHASES - 1) ? 10 : 1 + (i - 1) % 7;
        const int reps = ((DUP_MASK >> kind) & 1) ? 2 : 1;
        for (int r = 0; r < reps; ++r) hipLaunchKernelGGL(fwd_kernel, dim3(grid), dim3(512), LDS_TOTAL, stream, p); }
#endif
}
```

```cpp
#include <hip/hip_runtime.h>
#include <hip/hip_cooperative_groups.h>
#include <cstdio>
namespace cg = cooperative_groups;
#ifndef SINGLE_LAUNCH
#define SINGLE_LAUNCH 1
#endif
__device__ __forceinline__ int opaque_tid() { int t = threadIdx.x; asm volatile("" : "+v"(t)); return t; }
namespace pg8 {
#define PG8_LAS __attribute__((address_space(3)))
typedef unsigned short bf16_t;
typedef short bf16x8 __attribute__((ext_vector_type(8)));
typedef float f32x4 __attribute__((ext_vector_type(4)));
typedef unsigned u32x4 __attribute__((ext_vector_type(4)));
constexpr int BM = 256, BK = 64, HALF = 128, HTB = HALF * BK * 2  , STAGE_BYTES = 8 * HTB, NXCD = 8, WGM = 8;

__host__ __device__ __forceinline__ int lds_byte(int r, int c) { const int st = (r >> 4) * 2 + (c >> 5), rr = r & 15, cc = c & 31, ob = rr * 64 + cc * 2; return st * 1024 + (ob ^ (((ob >> 9) & 1) << 5)); }
__host__ __device__ __forceinline__ void stage_rc(int b, int& R, int& C) { const int st = b / 1024, sb = b % 1024, swz = sb ^ (((sb >> 9) & 1) << 5); R = (st >> 1) * 16 + swz / 64; C = (st & 1) * 32 + (swz % 64) / 2; }
__host__ __device__ __forceinline__ int perm32(int rho) { const int n = rho >> 4, i = rho & 15; return 8 * (i >> 2) + 4 * n + (i & 3); }

struct Unit { int pm, pn, ui; };
struct Gemm { const bf16_t* A; const bf16_t* Bt; int M, N, K; };

struct StaticOrder {
    int nM, nN, nwg, G, c;
    __host__ __device__ void init(int M, int N, int G_, int c_) { nM = M / BM; nN = N / BM; nwg = nM * nN; G = G_; c = c_; }
    __host__ __device__ bool next(int i, Unit& u) const {
        const long L = (long)i * G + c; if (L >= nwg) return false;
        int wgid = (int)L; { const int q = nwg / NXCD, r = nwg % NXCD, xcd = wgid % NXCD, off = wgid / NXCD; wgid = (xcd < r ? xcd * (q + 1) : r * (q + 1) + (xcd - r) * q) + off; }
        const int nig = WGM * nN, gid = wgid / nig, fm = gid * WGM, gsz = (nM - fm) < WGM ? (nM - fm) : WGM;
        u.pm = fm + ((wgid % nig) % gsz); u.pn = (wgid % nig) / gsz; u.ui = i; return true;
    }
    __device__ __forceinline__ void a_ready(const Unit&) const {}
    __device__ __forceinline__ void done(const Unit&) const {}
};
__device__ __forceinline__ unsigned cvt_pk_bf16(float lo, float hi) { unsigned r; asm volatile("v_cvt_pk_bf16_f32 %0, %1, %2" : "=v"(r) : "v"(lo), "v"(hi)); return r; }
template <class Epi, class Sched, bool ALIGN_EPI = false, bool SP2 = false>
__device__ __forceinline__ void gemm_phase(PG8_LAS unsigned char* lds, const Gemm g, const Sched& S, const Epi& E) {
    const int tid = opaque_tid(), wid = __builtin_amdgcn_readfirstlane(tid >> 6), lane = tid & 63, wr = wid >> 2, wc = wid & 3, fr = lane & 15, fq = lane >> 4;
    const int K = g.K, nt = K / BK;
    unsigned voffA[2], voffB[2];
#pragma unroll
    for (int i = 0; i < 2; ++i) { int R, C; stage_rc(tid * 16 + i * 8192, R, C); const int Rb = Epi::PERM ? ((R & ~31) + perm32(R & 31)) : R;
        voffA[i] = (unsigned)(R * K + C) * 2u; voffB[i] = (unsigned)(Rb * K + C) * 2u; }
    const size_t kstep = (size_t)(BK * 2);
    const size_t hstep = (size_t)HALF * K * 2;
    const size_t tstep = 2 * hstep;
    const unsigned ldsw = (unsigned)wid * 1024u;
    const int aoff = lds_byte(wr * 64 + fr, fq * 8), boff = lds_byte(wc * 32 + fr, fq * 8);
#define PG8_SA(b, h) (((b) * 2 + (h)) * HTB)
#define PG8_SB(b, h) ((4 + (b) * 2 + (h)) * HTB)
#define PG8_STAGE(bufoff, gbase, voff) do { _Pragma("unroll") for (int _i = 0; _i < 2; ++_i) \
        __builtin_amdgcn_global_load_lds((const unsigned*)((const char*)(gbase) + (voff)[_i]), (PG8_LAS unsigned*)(lds + (bufoff) + ldsw + _i * 8192), 16, 0, 0); } while (0)
#define PG8_LDA(dst, b, h) do { _Pragma("unroll") for (int m = 0; m < 4; ++m) _Pragma("unroll") for (int k = 0; k < 2; ++k) dst[m][k] = *(const PG8_LAS bf16x8*)(lds + PG8_SA(b, h) + aoff + m * 2048 + k * 1024); } while (0)
#define PG8_LDB(dst, b, h) do { _Pragma("unroll") for (int n = 0; n < 2; ++n) _Pragma("unroll") for (int k = 0; k < 2; ++k) dst[n][k] = *(const PG8_LAS bf16x8*)(lds + PG8_SB(b, h) + boff + n * 2048 + k * 1024); } while (0)
#define PG8_MMA(ai, bj, At, Bt) do { __builtin_amdgcn_s_setprio(1); _Pragma("unroll") for (int m = 0; m < 4; ++m) _Pragma("unroll") for (int n = 0; n < 2; ++n) _Pragma("unroll") for (int k = 0; k < 2; ++k) \
        acc[ai][bj][m][n] = __builtin_amdgcn_mfma_f32_16x16x32_bf16(Bt[n][k], At[m][k], acc[ai][bj][m][n], 0, 0, 0); __builtin_amdgcn_s_setprio(0); } while (0)
#define PG8_WAIT_V(n) asm volatile("s_waitcnt vmcnt(" #n ")" ::: "memory")
#define PG8_WAIT_L(n) asm volatile("s_waitcnt lgkmcnt(" #n ")" ::: "memory")
#define PG8_BAR __builtin_amdgcn_s_barrier()
#define PG8_SCHED __builtin_amdgcn_sched_barrier(0)
    Unit cur, nxt; int ui = 0;
    if (!S.next(0, cur)) return;
    f32x4 acc[2][2][4][2];
    u32x4 raw_init[2][4][2];
    if constexpr (Epi::INIT_ACC) E.load_init(raw_init, cur, wr, wc, fr, fq);
    else {
#pragma unroll
    for (int a = 0; a < 2; ++a)
#pragma unroll
        for (int b = 0; b < 2; ++b)
#pragma unroll
            for (int m = 0; m < 4; ++m)
#pragma unroll
                for (int n = 0; n < 2; ++n) acc[a][b][m][n] = (f32x4){0.f, 0.f, 0.f, 0.f};
    }
    bf16x8 At[4][2], B0[2][2], B1[2][2];
    const char* cA = (const char*)g.A + (size_t)cur.pm * tstep; const char* cB = (const char*)g.Bt + (size_t)cur.pn * tstep;
    S.a_ready(cur);
    if constexpr (SP2) {
        PG8_STAGE(PG8_SB(0, 0), cB, voffB); PG8_STAGE(PG8_SB(0, 1), cB + hstep, voffB); PG8_STAGE(PG8_SA(0, 0), cA, voffA); PG8_STAGE(PG8_SA(0, 1), cA + hstep, voffA);
        if (wr == 1) PG8_BAR;
        PG8_WAIT_V(2); PG8_BAR;
        PG8_STAGE(PG8_SB(1, 0), cB + kstep, voffB); PG8_STAGE(PG8_SA(1, 0), cA + kstep, voffA); PG8_STAGE(PG8_SB(1, 1), cB + hstep + kstep, voffB);
        if constexpr (Epi::HAS_PRE) E.pre(S);
        PG8_WAIT_V(6); PG8_BAR;
    } else {
        PG8_STAGE(PG8_SB(0, 0), cB, voffB); PG8_STAGE(PG8_SA(0, 0), cA, voffA); PG8_STAGE(PG8_SB(0, 1), cB + hstep, voffB); PG8_STAGE(PG8_SA(0, 1), cA + hstep, voffA);
        if (wr == 1) PG8_BAR;
        PG8_WAIT_V(4); PG8_BAR;
        PG8_STAGE(PG8_SB(1, 0), cB + kstep, voffB); PG8_STAGE(PG8_SA(1, 0), cA + kstep, voffA); PG8_STAGE(PG8_SB(1, 1), cB + hstep + kstep, voffB);
        PG8_WAIT_V(6); PG8_BAR;
    }
    if constexpr (Epi::INIT_ACC) { PG8_SCHED; E.unpack_init(acc, raw_init); PG8_SCHED; }
    for (;;) {
        const bool has_next = S.next(ui + 1, nxt);
        const char* nA = has_next ? (const char*)g.A + (size_t)nxt.pm * tstep : cA; const char* nB = has_next ? (const char*)g.Bt + (size_t)nxt.pn * tstep : cB;
        for (int t = 0; t < nt; t += 2) {
            const bool last = (t == nt - 2);
            const char* a1 = cA + (size_t)(t + 1) * kstep;
            const char* a2 = last ? nA : cA + (size_t)(t + 2) * kstep; const char* b2 = last ? nB : cB + (size_t)(t + 2) * kstep;
            const char* a3 = a2 + kstep; const char* b3 = b2 + kstep;
            if (last && has_next) S.a_ready(nxt);
            if constexpr (SP2) {
            PG8_LDB(B0, 0, 0); PG8_LDB(B1, 0, 1); PG8_SCHED; PG8_LDA(At, 0, 0); PG8_STAGE(PG8_SA(1, 1), a1 + hstep, voffA);
            PG8_WAIT_V(8); PG8_WAIT_L(0); PG8_BAR; PG8_MMA(0, 0, At, B0); PG8_MMA(0, 1, At, B1); PG8_BAR; PG8_SCHED;
            PG8_LDA(At, 0, 1); PG8_STAGE(PG8_SB(0, 0), b2, voffB); PG8_STAGE(PG8_SB(0, 1), b2 + hstep, voffB); PG8_STAGE(PG8_SA(0, 0), a2, voffA);
            PG8_WAIT_V(8); PG8_WAIT_L(0); PG8_BAR; PG8_MMA(1, 0, At, B0); PG8_MMA(1, 1, At, B1); PG8_BAR; PG8_SCHED;
            PG8_LDB(B0, 1, 0); PG8_LDB(B1, 1, 1); PG8_SCHED; PG8_LDA(At, 1, 0); PG8_STAGE(PG8_SA(0, 1), a2 + hstep, voffA);
            PG8_WAIT_V(8); PG8_WAIT_L(0); PG8_BAR; PG8_MMA(0, 0, At, B0); PG8_MMA(0, 1, At, B1); PG8_BAR; PG8_SCHED;
            PG8_LDA(At, 1, 1); PG8_STAGE(PG8_SB(1, 0), b3, voffB); PG8_STAGE(PG8_SB(1, 1), b3 + hstep, voffB); PG8_STAGE(PG8_SA(1, 0), a3, voffA);
            PG8_WAIT_V(8); PG8_WAIT_L(0); PG8_BAR; PG8_MMA(1, 0, At, B0); PG8_MMA(1, 1, At, B1); PG8_BAR; PG8_SCHED;
            } else {
            PG8_LDB(B0, 0, 0); PG8_SCHED; PG8_LDA(At, 0, 0); PG8_STAGE(PG8_SA(1, 1), a1 + hstep, voffA);
            PG8_WAIT_L(8); PG8_BAR; PG8_WAIT_L(0); PG8_MMA(0, 0, At, B0); PG8_BAR; PG8_SCHED;
            PG8_LDB(B1, 0, 1); PG8_STAGE(PG8_SB(0, 0), b2, voffB);
            PG8_BAR; PG8_WAIT_L(0); PG8_MMA(0, 1, At, B1); PG8_BAR;
            PG8_LDA(At, 0, 1); PG8_STAGE(PG8_SA(0, 0), a2, voffA);
            PG8_BAR; PG8_WAIT_L(0); PG8_MMA(1, 0, At, B0); PG8_BAR; PG8_SCHED;
            PG8_STAGE(PG8_SB(0, 1), b2 + hstep, voffB);
            PG8_WAIT_V(6); PG8_BAR; PG8_MMA(1, 1, At, B1); PG8_BAR;
            PG8_LDB(B0, 1, 0); PG8_SCHED; PG8_LDA(At, 1, 0); PG8_STAGE(PG8_SA(0, 1), a2 + hstep, voffA);
            PG8_WAIT_L(8); PG8_BAR; PG8_WAIT_L(0); PG8_MMA(0, 0, At, B0); PG8_BAR; PG8_SCHED;
            PG8_LDB(B1, 1, 1); PG8_STAGE(PG8_SB(1, 0), b3, voffB);
            PG8_BAR; PG8_WAIT_L(0); PG8_MMA(0, 1, At, B1); PG8_BAR;
            PG8_LDA(At, 1, 1); PG8_STAGE(PG8_SA(1, 0), a3, voffA);
            PG8_BAR; PG8_WAIT_L(0); PG8_MMA(1, 0, At, B0); PG8_BAR; PG8_SCHED;
            PG8_STAGE(PG8_SB(1, 1), b3 + hstep, voffB);
            PG8_WAIT_V(6); PG8_BAR; PG8_MMA(1, 1, At, B1); PG8_BAR;
            }
        }
        if constexpr (ALIGN_EPI) { if (wr == 0) PG8_BAR; }
        if constexpr (!Epi::AFTER_DRAIN) { E(acc, cur, wr, wc, fr, fq); S.done(cur); }
        if (!has_next) break;
        if constexpr (Epi::INIT_ACC) { E.load_init(raw_init, nxt, wr, wc, fr, fq); E.unpack_init(acc, raw_init); }
        else {
#pragma unroll
        for (int a = 0; a < 2; ++a)
#pragma unroll
            for (int b = 0; b < 2; ++b)
#pragma unroll
                for (int m = 0; m < 4; ++m)
#pragma unroll
                    for (int n = 0; n < 2; ++n) acc[a][b][m][n] = (f32x4){0.f, 0.f, 0.f, 0.f};
        }
        cur = nxt; cA = nA; cB = nB; ++ui;
        if constexpr (ALIGN_EPI) { if (wr == 1) PG8_BAR; }
    }
    PG8_WAIT_V(0);
    if constexpr (!ALIGN_EPI) { if (wr == 0) PG8_BAR; }
    PG8_BAR;
    if constexpr (Epi::AFTER_DRAIN) { E.fused(acc, cur, wr, wc, fr, fq, lds, wid, lane); S.done(cur); }
#undef PG8_SA
#undef PG8_SB
#undef PG8_STAGE
#undef PG8_LDA
#undef PG8_LDB
#undef PG8_MMA
#undef PG8_WAIT_V
#undef PG8_WAIT_L
#undef PG8_BAR
#undef PG8_SCHED
}
}
#define XB_TMO      128
#define XB_XCNT(j)  (256  + 64 * (j))
#define XB_XSUB(j)  (1280 + 64 * (j))
#define XB_XGEN(j)  (2304 + 64 * (j))
#define XB_TOP      3328
#define XB_TOPGEN   3392
#define XCD_BAR_WORDS 3456
#define XB_SPIN_CAP (1u << 18)

__device__ __forceinline__ unsigned xb_ld(unsigned* p)              { return __hip_atomic_load(p, __ATOMIC_RELAXED, __HIP_MEMORY_SCOPE_AGENT); }
__device__ __forceinline__ unsigned xb_add(unsigned* p, unsigned v) { return __hip_atomic_fetch_add(p, v, __ATOMIC_RELAXED, __HIP_MEMORY_SCOPE_AGENT); }
__device__ __forceinline__ unsigned xb_xcc_id() { return (unsigned)__builtin_amdgcn_s_getreg((3 << 11) | 20) & 0xFu; }
#define XB_SPIN(cond, bar) do { unsigned _sp = 0; while (cond) { __builtin_amdgcn_s_sleep(1); \
    if ((++_sp & 255u) == 0u) { if (xb_ld(&(bar)[XB_TMO])) break; if (_sp > XB_SPIN_CAP) { atomicAdd(&(bar)[XB_TMO], 1u); break; } } } } while (0)

struct XcdBarrier {
    unsigned* bar; unsigned x;
    volatile PG8_LAS unsigned* st;
};

__device__ __forceinline__ XcdBarrier xcd_barrier_post(unsigned* bar, volatile PG8_LAS unsigned* st) {
    XcdBarrier b; b.bar = bar; b.x = xb_xcc_id(); b.st = st;
    if (threadIdx.x == 0) (void)xb_add(&bar[XB_XCNT(b.x)], 1u);
    return b;
}
__device__ __forceinline__ void xcd_barrier_complete(unsigned* bar, unsigned x, unsigned& nloc, unsigned& nx) {
    const unsigned G = gridDim.x * gridDim.y * gridDim.z;
    unsigned sum, cnt, mine, sp = 0u;
    for (;;) {
        sum = 0u; cnt = 0u; mine = 0u;
#pragma unroll
        for (unsigned j = 0; j < 16; ++j) { const unsigned c = xb_ld(&bar[XB_XCNT(j)]); sum += c; cnt += (c > 0u) ? 1u : 0u; mine = (j == x) ? c : mine; }
        if (sum == G) break;
        __builtin_amdgcn_s_sleep(1);
        if ((++sp & 255u) == 0u) { if (xb_ld(&bar[XB_TMO])) break; if (sp > XB_SPIN_CAP) { atomicAdd(&bar[XB_TMO], 1u); break; } }
    }
    nloc = mine > 0u ? mine : 1u; nx = cnt > 0u ? cnt : 1u;
}

__device__ __forceinline__ void xcd_barrier(const XcdBarrier& b) {
    asm volatile("s_waitcnt vmcnt(0)" ::: "memory");
    __syncthreads();
    if (threadIdx.x == 0) {
        unsigned* bar = b.bar;
        __builtin_amdgcn_s_waitcnt(0);
        unsigned nloc = b.st[0], nx = b.st[1];
        if (nloc == 0u) { xcd_barrier_complete(bar, b.x, nloc, nx); b.st[0] = nloc; b.st[1] = nx; }
        const unsigned old = xb_add(&bar[XB_XSUB(b.x)], 1u);
        const unsigned gen = old / nloc;
        if (old + 1u == (gen + 1u) * nloc) {
            __builtin_amdgcn_fence(__ATOMIC_RELEASE, "agent");
            asm volatile("s_waitcnt vmcnt(0)" ::: "memory");
            const unsigned og = xb_add(&bar[XB_TOP], 1u);
            const unsigned tg = og / nx;
            if (og + 1u == (tg + 1u) * nx) xb_add(&bar[XB_TOPGEN], 1u);
            else XB_SPIN(xb_ld(&bar[XB_TOPGEN]) == tg, bar);
            __builtin_amdgcn_fence(__ATOMIC_ACQUIRE, "agent");
            xb_add(&bar[XB_XGEN(b.x)], 1u);
            asm volatile("s_waitcnt vmcnt(0)" ::: "memory");
        } else {
            XB_SPIN(xb_ld(&bar[XB_XGEN(b.x)]) == gen, bar);
            __builtin_amdgcn_fence(__ATOMIC_ACQUIRE, "agent");
            asm volatile("s_waitcnt vmcnt(0)" ::: "memory");
        }
    }
    __syncthreads();
}
using pg8::bf16_t; using pg8::bf16x8; using pg8::f32x4; using pg8::u32x4; using pg8::cvt_pk_bf16;
#define LAS PG8_LAS
typedef unsigned u32x2 __attribute__((ext_vector_type(2)));
typedef float f32x2 __attribute__((ext_vector_type(2)));

constexpr int SEQ = 16384, DM = 1024, DEPTH = 4, PIN = 2576, PN = 2816, DFF = 2816, DLRU = 512, NCH = 256, CHUNK = 64;
constexpr int C_LG = 512, C_Q = 1024, C_K = 1280, C_V = 1536, C_G = 2048, C_Z = 2560;
constexpr float EPS = 1e-6f;
constexpr size_t al256(size_t x) { return (x + 255) & ~(size_t)255; }
constexpr size_t WS_WIN = 0;
constexpr size_t WS_WOUT = WS_WIN + al256((size_t)DEPTH * PN * DM * 2);
constexpr size_t WS_WF1 = WS_WOUT + al256((size_t)DEPTH * DM * DM * 2);
constexpr size_t WS_WF2 = WS_WF1 + al256((size_t)DEPTH * 2 * DFF * DM * 2);
constexpr size_t WS_WG = WS_WF2 + al256((size_t)DEPTH * DM * DFF * 2);
constexpr size_t WS_XN = WS_WG + al256((size_t)DEPTH * 2 * 8 * 64 * 64 * 2);
constexpr size_t WS_P = WS_XN + al256((size_t)SEQ * DM * 2);
constexpr size_t WS_MIX = WS_P + al256((size_t)SEQ * PN * 2);
constexpr size_t WS_U = WS_MIX + al256((size_t)SEQ * DM * 2);
constexpr size_t WS_HL = WS_U + al256((size_t)NCH * 32768 * 4);
constexpr size_t WS_DEC = WS_HL + al256((size_t)SEQ * DLRU * 4);
constexpr size_t WS_PT = WS_DEC + al256((size_t)NCH * 256 * 4);
constexpr size_t WS_HE = WS_PT + al256((size_t)NCH * DLRU * 4);
constexpr size_t WS_SS = WS_HE + al256((size_t)NCH * DLRU * 4);
constexpr size_t WS_BAR = WS_SS + al256((size_t)16 * SEQ * 4);
constexpr size_t WS_SB = WS_BAR + al256((size_t)XCD_BAR_WORDS * 4);
constexpr size_t WS_END = WS_SB + al256((size_t)NCH * 32768 * 2);
constexpr int WAVE_LDS = 18432, LDS_BYTES = 8 * WAVE_LDS;
static_assert(LDS_BYTES >= pg8::STAGE_BYTES, "lds");

struct Params {
    const float* x; const float* norm1; const float* w_in; const float* conv_w; const float* conv_b; const float* lru_wa; const float* lru_ba; const float* lru_wi; const float* lru_bi;
    const float* lru_lambda; const float* gla_w_alpha; const float* gla_b_alpha; const float* gla_norm; const float* w_out; const float* norm2; const float* w_ffn_in; const float* w_ffn_out; const float* final_norm;
    float* out; unsigned char* ws; int ph_lo, ph_hi;
};

__device__ __forceinline__ unsigned f2bf(float f) { unsigned u = __builtin_bit_cast(unsigned, f); return (u + 0x7fffu + ((u >> 16) & 1u)) >> 16; }
__device__ __forceinline__ float bf2f(unsigned short b) { return __builtin_bit_cast(float, ((unsigned)b) << 16); }
__device__ __forceinline__ float bflo(unsigned w) { return __builtin_bit_cast(float, w << 16); }
__device__ __forceinline__ float bfhi(unsigned w) { return __builtin_bit_cast(float, w & 0xffff0000u); }
__device__ __forceinline__ float fast_sigmoid(float x) { return __builtin_amdgcn_rcpf(1.0f + __builtin_amdgcn_exp2f(-1.4426950408889634f * x)); }
__device__ __forceinline__ float silu_f(float x) { return x * fast_sigmoid(x); }
__device__ __forceinline__ float gelu_tanh_f(float x) { const float y = 0.7978845608028654f * (x + 0.044715f * x * x * x); return x * fast_sigmoid(2.0f * y); }
#define MFMA16(a, b, c) __builtin_amdgcn_mfma_f32_16x16x32_bf16(a, b, c, 0, 0, 0)

__device__ __forceinline__ float row_rstd(const float* ssp, int row) {
    const f32x4 a = *(const f32x4*)(ssp + (size_t)row * 16), b = *(const f32x4*)(ssp + (size_t)row * 16 + 4), c = *(const f32x4*)(ssp + (size_t)row * 16 + 8), d = *(const f32x4*)(ssp + (size_t)row * 16 + 12);
    const float s = ((a[0] + a[1]) + (a[2] + a[3])) + ((b[0] + b[1]) + (b[2] + b[3])) + (((c[0] + c[1]) + (c[2] + c[3])) + ((d[0] + d[1]) + (d[2] + d[3])));
    return __builtin_amdgcn_rsqf(s * (1.0f / DM) + EPS); }
constexpr int RST_OFF = pg8::STAGE_BYTES;
template <class Sched> __device__ __forceinline__ void fill_rstd(LAS unsigned char* lds, const Sched& S, const float* ssp) {
    const int tid = opaque_tid(); LAS float* rst = (LAS float*)(lds + RST_OFF);
    for (int i = (tid >> 8); i < 8; i += 2) { pg8::Unit u; if (!S.next(i, u)) break; rst[i * 256 + (tid & 255)] = row_rstd(ssp, u.pm * 256 + (tid & 255)); }
    __syncthreads();
}
struct EpiStoreBf16 {
    static constexpr bool PERM = true, AFTER_DRAIN = false, INIT_ACC = false, HAS_PRE = true;
    bf16_t* O; int ldc; LAS float* rst; const float* ssp;
    template <class Sched> __device__ __forceinline__ void pre(const Sched& S) const {
        const int tid = opaque_tid();
        for (int i = (tid >> 8); i < 8; i += 2) { pg8::Unit u; if (!S.next(i, u)) break; rst[i * 256 + (tid & 255)] = row_rstd(ssp, u.pm * 256 + (tid & 255)); }
    }
    __device__ __forceinline__ void operator()(const f32x4 (&acc)[2][2][4][2], const pg8::Unit& u, int wr, int wc, int fr, int fq) const {
        const int row0 = u.pm * 256 + wr * 64 + fr, col0 = u.pn * 256 + wc * 32 + 8 * fq;
#pragma unroll
        for (int ai = 0; ai < 2; ++ai)
#pragma unroll
            for (int m = 0; m < 4; ++m) { const int row = row0 + ai * 128 + m * 16; const float rs = rst[u.ui * 256 + wr * 64 + fr + ai * 128 + m * 16]; bf16_t* rowp = O + (size_t)row * ldc + col0;
#pragma unroll
                for (int bj = 0; bj < 2; ++bj) { const f32x4 v0 = acc[ai][bj][m][0] * rs, v1 = acc[ai][bj][m][1] * rs;
                    u32x4 w; w.x = cvt_pk_bf16(v0[0], v0[1]); w.y = cvt_pk_bf16(v0[2], v0[3]); w.z = cvt_pk_bf16(v1[0], v1[1]); w.w = cvt_pk_bf16(v1[2], v1[3]);
                    *(u32x4*)(rowp + bj * 128) = w; } }
    }
};
struct EpiSwiglu {
    static constexpr bool PERM = true, AFTER_DRAIN = false, INIT_ACC = false, HAS_PRE = true;
    bf16_t* O; int ldc; LAS float* rst; const float* ssp;
    template <class Sched> __device__ __forceinline__ void pre(const Sched& S) const {
        const int tid = opaque_tid();
        for (int i = (tid >> 8); i < 8; i += 2) { pg8::Unit u; if (!S.next(i, u)) break; rst[i * 256 + (tid & 255)] = row_rstd(ssp, u.pm * 256 + (tid & 255)); }
    }
    __device__ __forceinline__ void operator()(const f32x4 (&acc)[2][2][4][2], const pg8::Unit& u, int wr, int wc, int fr, int fq) const {
        const int row0 = u.pm * 256 + wr * 64 + fr, col0 = u.pn * 128 + wc * 32 + 8 * fq;
#pragma unroll
        for (int ai = 0; ai < 2; ++ai)
#pragma unroll
            for (int m = 0; m < 4; ++m) { const int row = row0 + ai * 128 + m * 16; const float rs = rst[u.ui * 256 + wr * 64 + fr + ai * 128 + m * 16]; bf16_t* rowp = O + (size_t)row * ldc + col0;
                const float rs2 = rs * rs, c1 = -1.4426950408889634f * rs;
                const f32x4 g0 = acc[ai][0][m][0], g1 = acc[ai][0][m][1], u0 = acc[ai][1][m][0], u1 = acc[ai][1][m][1];
                const f32x4 t0 = g0 * c1, t1 = g1 * c1;
                f32x4 d0, d1;
#pragma unroll
                for (int j = 0; j < 4; ++j) { d0[j] = __builtin_amdgcn_exp2f(t0[j]); d1[j] = __builtin_amdgcn_exp2f(t1[j]); }
                d0 = d0 + 1.0f; d1 = d1 + 1.0f;
                f32x4 r0, r1;
#pragma unroll
                for (int j = 0; j < 4; ++j) { r0[j] = __builtin_amdgcn_rcpf(d0[j]); r1[j] = __builtin_amdgcn_rcpf(d1[j]); }
                const f32x4 v0 = ((g0 * u0) * rs2) * r0, v1 = ((g1 * u1) * rs2) * r1;
                u32x4 w; w.x = cvt_pk_bf16(v0[0], v0[1]); w.y = cvt_pk_bf16(v0[2], v0[3]); w.z = cvt_pk_bf16(v1[0], v1[1]); w.w = cvt_pk_bf16(v1[2], v1[3]);
                *(u32x4*)rowp = w; }
    }
};
struct EpiRes {
    static constexpr bool PERM = true, AFTER_DRAIN = false, INIT_ACC = true, HAS_PRE = false;
    bf16_t* xb; float* ss; int ldc;
    __device__ __forceinline__ void load_init(u32x4 (&raw)[2][4][2], const pg8::Unit& u, int wr, int wc, int fr, int fq) const {
        const int row0 = u.pm * 256 + wr * 64 + fr, col0 = u.pn * 256 + wc * 32 + 8 * fq;
#pragma unroll
        for (int ai = 0; ai < 2; ++ai)
#pragma unroll
            for (int m = 0; m < 4; ++m)
#pragma unroll
                for (int bj = 0; bj < 2; ++bj) raw[ai][m][bj] = *(const u32x4*)(xb + (size_t)(row0 + ai * 128 + m * 16) * ldc + col0 + bj * 128);
    }
    __device__ __forceinline__ void unpack_init(f32x4 (&acc)[2][2][4][2], const u32x4 (&raw)[2][4][2]) const {
#pragma unroll
        for (int ai = 0; ai < 2; ++ai)
#pragma unroll
            for (int m = 0; m < 4; ++m)
#pragma unroll
                for (int bj = 0; bj < 2; ++bj) { const u32x4 b = raw[ai][m][bj];
                    acc[ai][bj][m][0] = (f32x4){bflo(b.x), bfhi(b.x), bflo(b.y), bfhi(b.y)}; acc[ai][bj][m][1] = (f32x4){bflo(b.z), bfhi(b.z), bflo(b.w), bfhi(b.w)}; }
    }
    __device__ __forceinline__ void operator()(const f32x4 (&acc)[2][2][4][2], const pg8::Unit& u, int wr, int wc, int fr, int fq) const {
        const int row0 = u.pm * 256 + wr * 64 + fr, col0 = u.pn * 256 + wc * 32 + 8 * fq;
#pragma unroll
        for (int ai = 0; ai < 2; ++ai)
#pragma unroll
            for (int m = 0; m < 4; ++m) { const int row = row0 + ai * 128 + m * 16; const size_t off = (size_t)row * ldc + col0; float s = 0.f;
#pragma unroll
                for (int bj = 0; bj < 2; ++bj) { const f32x4 v0 = acc[ai][bj][m][0], v1 = acc[ai][bj][m][1];
                    u32x4 w; w.x = cvt_pk_bf16(v0[0], v0[1]); w.y = cvt_pk_bf16(v0[2], v0[3]); w.z = cvt_pk_bf16(v1[0], v1[1]); w.w = cvt_pk_bf16(v1[2], v1[3]);
                    *(u32x4*)(xb + off + bj * 128) = w;
                    s += v0[0] * v0[0] + v0[1] * v0[1] + v0[2] * v0[2] + v0[3] * v0[3] + v1[0] * v1[0] + v1[1] * v1[1] + v1[2] * v1[2] + v1[3] * v1[3]; }
                s += __shfl_xor(s, 16); s += __shfl_xor(s, 32);
                if (fq == 0) ss[(size_t)row * 16 + u.pn * 4 + wc] = s; }
    }
};

struct PrepTile { const float* src; const float* gain; bf16_t* dst; int ld, Kd, k0, n0, kind, l; };
__device__ __forceinline__ PrepTile prep_decode(const Params& p, int tix) {
    constexpr int T0 = 160, T1 = 16, T2 = 64, T3 = 352, T4 = 176, TL = T0 + T1 + T2 + T3 + T4;
    PrepTile t; const int l = tix / TL; int r = tix % TL; int kind;
    if (r < T0) kind = 0; else if ((r -= T0) < T1) kind = 1; else if ((r -= T1) < T2) kind = 2; else if ((r -= T2) < T3) kind = 3; else { r -= T3; kind = 4; }
    t.kind = kind; t.l = l; t.Kd = (kind == 4) ? DFF : DM; const int nkt = t.Kd / 64; t.k0 = (r % nkt) * 64; const int nt = r / nkt; t.n0 = nt * 256; t.gain = nullptr;
    if (kind == 0) { t.src = p.w_in + (size_t)l * DM * PIN + t.n0; t.ld = PIN; t.gain = p.norm1 + l * DM; t.dst = (bf16_t*)(p.ws + WS_WIN) + (size_t)l * PN * DM; }
    else if (kind == 1) { t.src = p.w_in + (size_t)l * DM * PIN + C_Z; t.ld = PIN; t.gain = p.norm1 + l * DM; t.dst = (bf16_t*)(p.ws + WS_WIN) + (size_t)l * PN * DM; t.n0 = C_Z; }
    else if (kind == 2) { t.src = p.w_out + (size_t)l * DM * DM + t.n0; t.ld = DM; t.dst = (bf16_t*)(p.ws + WS_WOUT) + (size_t)l * DM * DM; }
    else if (kind == 3) { t.src = p.w_ffn_in + (size_t)l * DM * 2 * DFF + 128 * nt; t.ld = 2 * DFF; t.gain = p.norm2 + l * DM; t.dst = (bf16_t*)(p.ws + WS_WF1) + (size_t)l * 2 * DFF * DM; }
    else { t.src = p.w_ffn_out + (size_t)l * DFF * DM + t.n0; t.ld = DM; t.dst = (bf16_t*)(p.ws + WS_WF2) + (size_t)l * DM * DFF; }
    return t;
}
__device__ __forceinline__ void prep_load(const Params& p, const PrepTile& t, int tid, f32x4 (&v)[8]) {
    const int n4 = (tid & 63) * 4, kw = tid >> 6;
    if (t.kind == 1) { const float* wa = p.gla_w_alpha + (size_t)t.l * 16 * 256 + n4;
#pragma unroll
        for (int i = 0; i < 8; ++i) v[i] = (f32x4){0.f, 0.f, 0.f, 0.f};
#pragma unroll
        for (int hf = 0; hf < 2; ++hf) { f32x4 a[8], z[8][2];
#pragma unroll
            for (int rr = 0; rr < 8; ++rr) a[rr] = *(const f32x4*)(wa + (hf * 8 + rr) * 256);
#pragma unroll
            for (int i = 0; i < 8; ++i) { const float* zr = t.src + (size_t)(t.k0 + i * 8 + kw) * t.ld + hf * 8; z[i][0] = *(const f32x4*)zr; z[i][1] = *(const f32x4*)(zr + 4); }
#pragma unroll
            for (int i = 0; i < 8; ++i)
#pragma unroll
                for (int rr = 0; rr < 8; ++rr) v[i] += a[rr] * z[i][rr >> 2][rr & 3]; }
    } else { const int sc = (t.kind == 3 && n4 >= 128) ? (DFF - 128 + n4) : n4;
#pragma unroll
        for (int i = 0; i < 8; ++i) v[i] = *(const f32x4*)(t.src + (size_t)(t.k0 + i * 8 + kw) * t.ld + sc); }
    if (t.gain) {
#pragma unroll
        for (int i = 0; i < 8; ++i) v[i] *= t.gain[t.k0 + i * 8 + kw]; }
}
__device__ __forceinline__ void prep_tiles(const Params& p, LAS unsigned char* lds, const int tile_lo, const int tile_hi, const int rank, const int nranks) {
    LAS float* T = (LAS float*)lds;
    const int tid = opaque_tid();
    int tix = tile_lo + rank; f32x4 v[8]; PrepTile t;
    if (tix < tile_hi) { t = prep_decode(p, tix); prep_load(p, t, tid, v); }
    while (tix < tile_hi) {
        { const int n4 = (tid & 63) * 4, kw = tid >> 6;
#pragma unroll
            for (int i = 0; i < 8; ++i) { LAS float* d = T + (i * 8 + kw) * 257 + n4; d[0] = v[i][0]; d[1] = v[i][1]; d[2] = v[i][2]; d[3] = v[i][3]; } }
        __syncthreads();
        const PrepTile cur = t; tix += nranks;
        if (tix < tile_hi) { t = prep_decode(p, tix); prep_load(p, t, tid, v); }
        { const int kseg = tid & 7;
#pragma unroll
            for (int ps = 0; ps < 4; ++ps) { const int n = ps * 64 + (tid >> 3); const LAS float* s = T + (8 * kseg) * 257 + n;
                u32x4 w; w.x = cvt_pk_bf16(s[0], s[257]); w.y = cvt_pk_bf16(s[2 * 257], s[3 * 257]); w.z = cvt_pk_bf16(s[4 * 257], s[5 * 257]); w.w = cvt_pk_bf16(s[6 * 257], s[7 * 257]);
                *(u32x4*)(cur.dst + (size_t)(cur.n0 + n) * cur.Kd + cur.k0 + 8 * kseg) = w; } }
        __syncthreads();
    }
}
template <class Sched> __device__ __forceinline__ void prep_in_tail(const Params& p, LAS unsigned char* lds, const Sched& S, const int tile_lo, const int tile_hi) {
    const int rem = S.nwg % S.G;
    if (rem == 0) prep_tiles(p, lds, tile_lo, tile_hi, S.c, S.G);
    else if (S.c >= rem) prep_tiles(p, lds, tile_lo, tile_hi, S.c - rem, S.G - rem);
}
__device__ __forceinline__ void prep_gates(const Params& p) {
    const int tid = opaque_tid();
    bf16_t* wg = (bf16_t*)(p.ws + WS_WG);
    for (int idx = blockIdx.x * 512 + tid; idx < DEPTH * 2 * 8 * 4096; idx += gridDim.x * 512) {
        const int i = idx & 63, j = (idx >> 6) & 63, blk = (idx >> 12) & 7, g = (idx >> 15) & 1, l = idx >> 16;
        const float* s = (g ? p.lru_wi : p.lru_wa) + (size_t)l * 8 * 4096 + blk * 4096 + i * 64 + j;
        wg[idx] = (bf16_t)f2bf(-1.4426950408889634f * *s);
    }
}

__device__ __forceinline__ void x_to_bf16(const float* X, bf16_t* XB, float* SS0) {
    const int tid = opaque_tid(), lane = tid & 63, gw = blockIdx.x * 8 + (tid >> 6), nw = gridDim.x * 8;
#pragma unroll 2
    for (int r = gw; r < SEQ; r += nw) {
        const float* xr = X + (size_t)r * DM; f32x4 v[4]; float s = 0.f;
#pragma unroll
        for (int i = 0; i < 4; ++i) { v[i] = *(const f32x4*)(xr + i * 256 + lane * 4); s += v[i][0] * v[i][0] + v[i][1] * v[i][1] + v[i][2] * v[i][2] + v[i][3] * v[i][3]; }
#pragma unroll
        for (int o = 32; o >= 1; o >>= 1) s += __shfl_xor(s, o);
        if (lane < 16) SS0[(size_t)r * 16 + lane] = (lane == 0) ? s : 0.f;
#pragma unroll
        for (int i = 0; i < 4; ++i) { u32x2 w; w.x = cvt_pk_bf16(v[i][0], v[i][1]); w.y = cvt_pk_bf16(v[i][2], v[i][3]); *(u32x2*)(XB + (size_t)r * DM + i * 256 + lane * 4) = w; }
    }
}
__device__ __forceinline__ void final_norm(const bf16_t* XB, float* OUT, const float* ss, const float* gain) {
    const int tid = opaque_tid();
    const bool grouped = gridDim.x == 256;
    const int step = grouped ? 512 * 4 : gridDim.x * 512 * 4, first = grouped ? (2048 * (blockIdx.x & 7) + 64 * (blockIdx.x >> 3)) * 128 : blockIdx.x * 512 * 4, last = grouped ? first + 4 * step : SEQ * DM / 8;
    for (int base = first; base < last; base += step) {
        u32x4 v[4];
#pragma unroll
        for (int i = 0; i < 4; ++i) v[i] = *(const u32x4*)(XB + (size_t)(base + i * 512 + tid) * 8);
#pragma unroll
        for (int i = 0; i < 4; ++i) { const int e = (base + i * 512 + tid) * 8, row = e >> 10, col = e & 1023; const float rs = row_rstd(ss, row);
            const f32x4 g0 = *(const f32x4*)(gain + col), g1 = *(const f32x4*)(gain + col + 4);
            *(f32x4*)(OUT + (size_t)e) = (f32x4){bflo(v[i].x), bfhi(v[i].x), bflo(v[i].y), bfhi(v[i].y)} * rs * g0;
            *(f32x4*)(OUT + (size_t)e + 4) = (f32x4){bflo(v[i].z), bfhi(v[i].z), bflo(v[i].w), bfhi(v[i].w)} * rs * g1; }
    }
}
#define WAVE_SYNC() do { asm volatile("s_waitcnt lgkmcnt(0)" ::: "memory"); __builtin_amdgcn_wave_barrier(); asm volatile("" ::: "memory"); } while (0)
__device__ __forceinline__ bf16x8 pack8(const float (&v)[8]) { u32x4 w; w.x = cvt_pk_bf16(v[0], v[1]); w.y = cvt_pk_bf16(v[2], v[3]); w.z = cvt_pk_bf16(v[4], v[5]); w.w = cvt_pk_bf16(v[6], v[7]); return __builtin_bit_cast(bf16x8, w); }

__device__ __forceinline__ void mixer_a(const Params& p, const int l, LAS unsigned char* lds) {
    const int tid = opaque_tid(), lane = tid & 63, w = __builtin_amdgcn_readfirstlane(tid >> 6), c = lane & 15, q = lane >> 4;
    LAS unsigned char* wl = lds + w * WAVE_LDS;
    LAS bf16_t* xs = (LAS bf16_t*)wl;
    LAS float* sa = (LAS float*)wl;
    LAS float* su = (LAS float*)(wl + 4096);
    LAS bf16_t* xcs = (LAS bf16_t*)(wl + 8704);
    LAS bf16_t* zs = (LAS bf16_t*)wl;
    LAS bf16_t* ks = (LAS bf16_t*)(wl + 8192);
    LAS bf16_t* kdT = (LAS bf16_t*)wl;
    LAS unsigned char* vt = wl + 9216;
    const bf16_t* P = (const bf16_t*)(p.ws + WS_P);
    unsigned* HL = (unsigned*)(p.ws + WS_HL);
    float* U = (float*)(p.ws + WS_U); float* DEC = (float*)(p.ws + WS_DEC); float* PT = (float*)(p.ws + WS_PT); float* HE = (float*)(p.ws + WS_HE);
    const int hh = w >> 1, half = w & 1, seg = lane & 7, rsub = lane >> 3;
    for (int ch0 = blockIdx.x; ch0 < NCH; ch0 += gridDim.x) { const int ch = (gridDim.x == 256) ? 32 * (ch0 & 7) + (ch0 >> 3) : ch0;
        const int t0 = ch * CHUNK;
        bf16x8 Bw[2][4][2]; float rba[4], rbi[4], rlam[4];
        {   u32x4 xv[9];
#pragma unroll
            for (int it = 0; it < 9; ++it) { const int row = it * 8 + rsub, t = t0 - 3 + row; xv[it] = (u32x4){0u, 0u, 0u, 0u};
                if (row < 67 && t >= 0) xv[it] = *(const u32x4*)(P + (size_t)t * PN + 64 * w + 8 * seg); }
            const int gch = 64 * w + 8 * seg; f32x4 cwv[4][2], cbv[2];
#pragma unroll
            for (int j = 0; j < 4; ++j) { cwv[j][0] = *(const f32x4*)(p.conv_w + (size_t)(l * 4 + j) * DLRU + gch); cwv[j][1] = *(const f32x4*)(p.conv_w + (size_t)(l * 4 + j) * DLRU + gch + 4); }
            cbv[0] = *(const f32x4*)(p.conv_b + l * DLRU + gch); cbv[1] = *(const f32x4*)(p.conv_b + l * DLRU + gch + 4);
#pragma unroll
            for (int it = 0; it < 9; ++it) { const int row = it * 8 + rsub; if (row < 67) *(LAS u32x4*)(xs + row * 64 + 8 * seg) = xv[it]; }
            WAVE_SYNC();
            { const bf16_t* wg = (const bf16_t*)(p.ws + WS_WG) + (size_t)((l * 2) * 8 + w) * 4096;
#pragma unroll
              for (int g = 0; g < 2; ++g)
#pragma unroll
                for (int nt = 0; nt < 4; ++nt)
#pragma unroll
                    for (int k2 = 0; k2 < 2; ++k2) Bw[g][nt][k2] = *(const bf16x8*)(wg + (size_t)g * 8 * 4096 + (16 * nt + c) * 64 + 32 * k2 + 8 * q);
#pragma unroll
              for (int nt = 0; nt < 4; ++nt) { const int gc2 = 64 * w + 16 * nt + c; rba[nt] = p.lru_ba[l * DLRU + gc2]; rbi[nt] = p.lru_bi[l * DLRU + gc2]; rlam[nt] = p.lru_lambda[l * DLRU + gc2]; } }
#pragma unroll 1
            for (int i = 0; i < 8; ++i) { const int t = i * 8 + rsub; float xc[8];
#pragma unroll
                for (int e = 0; e < 4; ++e) { xc[e] = cbv[0][e]; xc[4 + e] = cbv[1][e]; }
#pragma unroll
                for (int j = 0; j < 4; ++j) { const u32x4 x4 = *(const LAS u32x4*)(xs + (t + j) * 64 + 8 * seg);
                    xc[0] += cwv[j][0][0] * bflo(x4.x); xc[1] += cwv[j][0][1] * bfhi(x4.x); xc[2] += cwv[j][0][2] * bflo(x4.y); xc[3] += cwv[j][0][3] * bfhi(x4.y);
                    xc[4] += cwv[j][1][0] * bflo(x4.z); xc[5] += cwv[j][1][1] * bfhi(x4.z); xc[6] += cwv[j][1][2] * bflo(x4.w); xc[7] += cwv[j][1][3] * bfhi(x4.w); }
                *(LAS bf16x8*)(xcs + t * 64 + 8 * seg) = pack8(xc); }
            WAVE_SYNC();
        }
        float ba[4], bi[4], sp[4];
#pragma unroll
        for (int nt = 0; nt < 4; ++nt) { ba[nt] = -1.4426950408889634f * rba[nt]; bi[nt] = -1.4426950408889634f * rbi[nt]; sp[nt] = -8.0f * 1.4426950408889634f * __logf(1.0f + __expf(-rlam[nt])); }
        float hst = 0.f, cp = 1.f;
#pragma unroll 1
        for (int mt = 0; mt < 4; ++mt) {
            const bf16x8 Af0 = *(const LAS bf16x8*)(xcs + (16 * mt + c) * 64 + 8 * q), Af1 = *(const LAS bf16x8*)(xcs + (16 * mt + c) * 64 + 32 + 8 * q);
#pragma unroll
            for (int nt = 0; nt < 4; ++nt) { const int chl = 16 * nt + c;
                f32x4 racc = {ba[nt], ba[nt], ba[nt], ba[nt]}, iacc = {bi[nt], bi[nt], bi[nt], bi[nt]};
                racc = MFMA16(Af0, Bw[0][nt][0], racc); racc = MFMA16(Af1, Bw[0][nt][1], racc); iacc = MFMA16(Af0, Bw[1][nt][0], iacc); iacc = MFMA16(Af1, Bw[1][nt][1], iacc);
#pragma unroll
                for (int reg = 0; reg < 4; ++reg) {
                    const float xc = bf2f(xcs[(16 * mt + 4 * q + reg) * 64 + chl]);
                    const float r = __builtin_amdgcn_rcpf(1.0f + __builtin_amdgcn_exp2f(racc[reg])), ig = __builtin_amdgcn_rcpf(1.0f + __builtin_amdgcn_exp2f(iacc[reg]));
                    const float a = __builtin_amdgcn_exp2f(sp[nt] * r);
                    const float om = __builtin_fmaf(-a, a, 1.0f);
                    sa[(4 * q + reg) * 64 + chl] = a; su[(4 * q + reg) * 64 + chl] = __builtin_amdgcn_sqrtf(om) * ig * xc; } }
            WAVE_SYNC();
            unsigned* hl = HL + (size_t)(t0 + 16 * mt) * DLRU + 64 * w + lane;
#pragma unroll
            for (int tt = 0; tt < 16; ++tt) { const float a = sa[tt * 64 + lane], u = su[tt * 64 + lane]; hst = a * hst + u; cp *= a; hl[(size_t)tt * DLRU] = cvt_pk_bf16(hst, cp); }
            WAVE_SYNC();
        }
        PT[ch * DLRU + 64 * w + lane] = cp; HE[ch * DLRU + 64 * w + lane] = hst;
        WAVE_SYNC();
        {   const int gc = 64 * hh + lane; const float zb = p.gla_b_alpha[l * 256 + gc];
            u32x4 zv[8], kv[8], vv[8];
#pragma unroll
            for (int it = 0; it < 8; ++it) { const bf16_t* row = P + (size_t)(t0 + it * 8 + rsub) * PN;
                zv[it] = *(const u32x4*)(row + C_Z + 64 * hh + 8 * seg); kv[it] = *(const u32x4*)(row + C_K + 64 * hh + 8 * seg); vv[it] = *(const u32x4*)(row + C_V + 128 * hh + 64 * half + 8 * seg); }
#pragma unroll
            for (int it = 0; it < 8; ++it) { *(LAS u32x4*)(zs + (it * 8 + rsub) * 64 + 8 * seg) = zv[it]; *(LAS u32x4*)(ks + (it * 8 + rsub) * 64 + 8 * seg) = kv[it]; }
            WAVE_SYNC();
            bf16x8 kdp[8]; float suf = 0.f;
#pragma unroll
            for (int t8 = 7; t8 >= 0; --t8) { float kd[8];
#pragma unroll
                for (int e = 7; e >= 0; --e) { const int t = 8 * t8 + e;
                    const float z = bf2f(zs[t * 64 + lane]) + zb, kk = bf2f(ks[t * 64 + lane]);
                    const float la = (fminf(z, 0.f) - __logf(1.0f + __expf(-fabsf(z)))) * 0.0625f;
                    kd[e] = kk * __expf(suf); suf += la; }
                kdp[t8] = pack8(kd); }
            if (half == 0) DEC[ch * 256 + gc] = __expf(suf);
            WAVE_SYNC();
#pragma unroll
            for (int t8 = 0; t8 < 8; ++t8) *(LAS bf16x8*)(kdT + lane * 72 + 8 * t8) = kdp[t8];
#pragma unroll
            for (int it = 0; it < 8; ++it) { LAS unsigned char* dst = vt + (it * 8 + rsub) * 136 + 16 * seg; *(LAS u32x2*)dst = (u32x2){vv[it].x, vv[it].y}; *(LAS u32x2*)(dst + 8) = (u32x2){vv[it].z, vv[it].w}; }
            WAVE_SYNC();
        }
        {   bf16x8 Ak[4][2];
#pragma unroll
            for (int mt = 0; mt < 4; ++mt)
#pragma unroll
                for (int k2 = 0; k2 < 2; ++k2) Ak[mt][k2] = *(const LAS bf16x8*)(kdT + (16 * mt + c) * 72 + 32 * k2 + 8 * q);
            float* Uc = U + (size_t)(ch * 4 + hh) * 64 * 128;
#pragma unroll
            for (int nt = 0; nt < 4; ++nt) { const int vl = 16 * nt + c, vcol = 64 * half + vl; bf16x8 Bv[2];
#pragma unroll
                for (int k2 = 0; k2 < 2; ++k2) { unsigned short tmp[8];
#pragma unroll
                    for (int e = 0; e < 8; ++e) tmp[e] = *(const LAS unsigned short*)(vt + (32 * k2 + 8 * q + e) * 136 + 2 * vl);
                    u32x4 wv; wv.x = tmp[0] | ((unsigned)tmp[1] << 16); wv.y = tmp[2] | ((unsigned)tmp[3] << 16); wv.z = tmp[4] | ((unsigned)tmp[5] << 16); wv.w = tmp[6] | ((unsigned)tmp[7] << 16);
                    Bv[k2] = __builtin_bit_cast(bf16x8, wv); }
#pragma unroll
                for (int mt = 0; mt < 4; ++mt) { f32x4 acc = {0.f, 0.f, 0.f, 0.f}; acc = MFMA16(Ak[mt][0], Bv[0], acc); acc = MFMA16(Ak[mt][1], Bv[1], acc);
                    *(f32x4*)(Uc + (size_t)vcol * 64 + 16 * mt + 4 * q) = acc; } } }
        __syncthreads();
    }
}

__device__ __forceinline__ void scan_phase(const Params& p, LAS unsigned char* lds) {
    LAS float* sx = (LAS float*)lds; LAS float* sd = sx + 512;
    const int tid = opaque_tid(), i = tid & 127, seg = tid >> 7;
    float* U = (float*)(p.ws + WS_U); const float* DEC = (const float*)(p.ws + WS_DEC); const float* PT = (const float*)(p.ws + WS_PT); float* HE = (float*)(p.ws + WS_HE);
    for (int vb = blockIdx.x; vb < 260; vb += gridDim.x) {
        const float* Dp; float* Up; size_t ds, us;
        if (vb < 256) { const int e = vb * 128 + i; Dp = DEC + ((e >> 13) << 6) + (e & 63); ds = 256; Up = U + e; us = 32768; }
        else { const int chn = (vb - 256) * 128 + i; Dp = PT + chn; ds = 512; Up = HE + chn; us = 512; }
        Dp += (size_t)seg * 64 * ds; Up += (size_t)seg * 64 * us;
        float d[64], u[64];
        { const float* dq = Dp; const float* uq = Up;
#pragma unroll
            for (int j = 0; j < 64; ++j) { d[j] = *dq; u[j] = *uq; dq += ds; uq += us; asm volatile("" : "+v"(dq), "+v"(uq)); } }
        float x = 0.f, dp = 1.f;
#pragma unroll
        for (int j = 0; j < 64; ++j) { x = d[j] * x + u[j]; dp *= d[j]; }
        sx[seg * 128 + i] = x; sd[seg * 128 + i] = dp;
        __syncthreads();
        float carry = 0.f;
        for (int s2 = 0; s2 < seg; ++s2) carry = sd[s2 * 128 + i] * carry + sx[s2 * 128 + i];
        x = carry;
        if (vb < 256) { bf16_t* sq = (bf16_t*)(p.ws + WS_SB) + (size_t)seg * 64 * 32768 + vb * 128 + i;
#pragma unroll
            for (int j = 0; j < 64; ++j) { x = d[j] * x + u[j]; *sq = (bf16_t)f2bf(x); sq += 32768; asm volatile("" : "+v"(sq)); } }
        else { float* uq = Up;
#pragma unroll
            for (int j = 0; j < 64; ++j) { x = d[j] * x + u[j]; *uq = x; uq += us; asm volatile("" : "+v"(uq)); } }
        __syncthreads();
    }
}

__device__ __forceinline__ void mixer_b(const Params& p, const int l, LAS unsigned char* lds) {
    const int tid = opaque_tid(), lane = tid & 63, w = __builtin_amdgcn_readfirstlane(tid >> 6), c = lane & 15, q = lane >> 4;
    LAS float* red = (LAS float*)lds;
    const bf16_t* P = (const bf16_t*)(p.ws + WS_P); bf16_t* MIX = (bf16_t*)(p.ws + WS_MIX);
    const unsigned* HL = (const unsigned*)(p.ws + WS_HL); const float* U = (const float*)(p.ws + WS_U); const float* HE = (const float*)(p.ws + WS_HE);
    const int hh = w >> 1, half = w & 1;
    for (int ch0 = blockIdx.x; ch0 < NCH; ch0 += gridDim.x) { const int ch = (gridDim.x == 256) ? 32 * (ch0 & 7) + (ch0 >> 3) : ch0;
        const int t0 = ch * CHUNK;
#define LRU_LOAD(it0_, h0_, h1_, g4_) do { _Pragma("unroll") for (int j = 0; j < 4; ++j) { const int idx = ((it0_) + j) * 512 + tid, t = idx >> 6; const size_t tok = (size_t)(t0 + t); \
            h0_[j] = *(const u32x4*)(HL + tok * DLRU + lc8); h1_[j] = *(const u32x4*)(HL + tok * DLRU + lc8 + 4); g4_[j] = *(const u32x4*)(P + tok * PN + C_LG + lc8); } } while (0)
#define LRU_COMP(it0_, h0_, h1_, g4_) do { _Pragma("unroll") for (int j = 0; j < 4; ++j) { const int idx = ((it0_) + j) * 512 + tid, t = idx >> 6; const size_t tok = (size_t)(t0 + t); float o[8]; \
            o[0] = (bflo(h0_[j].x) + bfhi(h0_[j].x) * ci0[0]) * gelu_tanh_f(bflo(g4_[j].x)); o[1] = (bflo(h0_[j].y) + bfhi(h0_[j].y) * ci0[1]) * gelu_tanh_f(bfhi(g4_[j].x)); \
            o[2] = (bflo(h0_[j].z) + bfhi(h0_[j].z) * ci0[2]) * gelu_tanh_f(bflo(g4_[j].y)); o[3] = (bflo(h0_[j].w) + bfhi(h0_[j].w) * ci0[3]) * gelu_tanh_f(bfhi(g4_[j].y)); \
            o[4] = (bflo(h1_[j].x) + bfhi(h1_[j].x) * ci1[0]) * gelu_tanh_f(bflo(g4_[j].z)); o[5] = (bflo(h1_[j].y) + bfhi(h1_[j].y) * ci1[1]) * gelu_tanh_f(bfhi(g4_[j].z)); \
            o[6] = (bflo(h1_[j].z) + bfhi(h1_[j].z) * ci1[2]) * gelu_tanh_f(bflo(g4_[j].w)); o[7] = (bflo(h1_[j].w) + bfhi(h1_[j].w) * ci1[3]) * gelu_tanh_f(bfhi(g4_[j].w)); \
            *(bf16x8*)(MIX + tok * DM + lc8) = pack8(o); } } while (0)
        const int lc8 = (tid & 63) * 8;
        f32x4 ci0 = {0.f, 0.f, 0.f, 0.f}, ci1 = {0.f, 0.f, 0.f, 0.f};
        if (ch > 0) { ci0 = *(const f32x4*)(HE + (size_t)(ch - 1) * DLRU + lc8); ci1 = *(const f32x4*)(HE + (size_t)(ch - 1) * DLRU + lc8 + 4); }
        u32x4 h0a[4], h1a[4], g4a[4];
        LRU_LOAD(0, h0a, h1a, g4a);
        const bf16_t* ST = (const bf16_t*)(p.ws + WS_SB) + (size_t)(ch * 4 + hh) * 8192 + (size_t)(64 * half + c) * 64 + 8 * q;
        bf16x8 As[4][2];
#pragma unroll
        for (int mt = 0; mt < 4; ++mt)
#pragma unroll
            for (int k2 = 0; k2 < 2; ++k2) As[mt][k2] = *(const bf16x8*)(ST + (size_t)(16 * mt) * 64 + 32 * k2);
        bf16x8 Bq[4][2];
#pragma unroll
        for (int nt = 0; nt < 4; ++nt)
#pragma unroll
            for (int k2 = 0; k2 < 2; ++k2) Bq[nt][k2] = *(const bf16x8*)(P + (size_t)(t0 + 16 * nt + c) * PN + C_Q + 64 * hh + 32 * k2 + 8 * q);
        f32x4 acc[4][4];
#pragma unroll
        for (int mt = 0; mt < 4; ++mt) { const bf16x8 As0 = As[mt][0], As1 = As[mt][1];
#pragma unroll
            for (int nt = 0; nt < 4; ++nt) { f32x4 a = {0.f, 0.f, 0.f, 0.f}; a = MFMA16(As0, Bq[nt][0], a); a = MFMA16(As1, Bq[nt][1], a); acc[mt][nt] = a * 0.125f; } }
        u32x2 gv[4][4];
#pragma unroll
        for (int mt = 0; mt < 4; ++mt)
#pragma unroll
            for (int nt = 0; nt < 4; ++nt) gv[mt][nt] = *(const u32x2*)(P + (size_t)(t0 + 16 * nt + c) * PN + C_G + 128 * hh + 64 * half + 16 * mt + 4 * q);
        float rstd[4];
#pragma unroll
        for (int nt = 0; nt < 4; ++nt) { float s = 0.f;
#pragma unroll
            for (int mt = 0; mt < 4; ++mt) { const f32x4 a = acc[mt][nt]; s += a[0] * a[0] + a[1] * a[1] + a[2] * a[2] + a[3] * a[3]; }
            s += __shfl_xor(s, 16); s += __shfl_xor(s, 32);
            if (q == 0) red[w * 64 + 16 * nt + c] = s; }
        __syncthreads();
#pragma unroll
        for (int nt = 0; nt < 4; ++nt) rstd[nt] = __builtin_amdgcn_rsqf((red[w * 64 + 16 * nt + c] + red[(w ^ 1) * 64 + 16 * nt + c]) * (1.0f / 128.0f) + EPS);
#pragma unroll
        for (int mt = 0; mt < 4; ++mt) { const int v0 = 64 * half + 16 * mt + 4 * q; const f32x4 gn = *(const f32x4*)(p.gla_norm + l * 128 + v0);
#pragma unroll
            for (int nt = 0; nt < 4; ++nt) { const size_t tok = (size_t)(t0 + 16 * nt + c);
                const f32x4 a = acc[mt][nt]; const float rs = rstd[nt]; const u32x2 g2 = gv[mt][nt];
                const float o0 = a[0] * rs * gn[0] * silu_f(bflo(g2.x)), o1 = a[1] * rs * gn[1] * silu_f(bfhi(g2.x)), o2 = a[2] * rs * gn[2] * silu_f(bflo(g2.y)), o3 = a[3] * rs * gn[3] * silu_f(bfhi(g2.y));
                u32x2 ov; ov.x = cvt_pk_bf16(o0, o1); ov.y = cvt_pk_bf16(o2, o3);
                *(u32x2*)(MIX + tok * DM + 512 + 128 * hh + v0) = ov; } }
        u32x4 h0b[4], h1b[4], g4b[4];
        LRU_LOAD(4, h0b, h1b, g4b);
        LRU_COMP(0, h0a, h1a, g4a);
        LRU_COMP(4, h0b, h1b, g4b);
        __syncthreads();
    }
}
#ifndef EN
#define EN 0xFFFF
#endif
constexpr int LDS_TOTAL = LDS_BYTES + 16;
#ifndef USE_CG
#define USE_CG 0
#endif
#ifndef INK_DUP
#define INK_DUP 0
#endif
#ifndef DUP_MASK
#define DUP_MASK 0
#endif
__device__ __forceinline__ void group_barrier(unsigned* bar, unsigned* cnt) {
    asm volatile("s_waitcnt vmcnt(0)" ::: "memory");
    __syncthreads();
    if (threadIdx.x == 0) {
        __builtin_amdgcn_fence(__ATOMIC_RELEASE, "agent"); asm volatile("s_waitcnt vmcnt(0)" ::: "memory");
        const unsigned old = xb_add(cnt, 1u), target = (old / 32u + 1u) * 32u;
        XB_SPIN(xb_ld(cnt) < target, bar);
        __builtin_amdgcn_fence(__ATOMIC_ACQUIRE, "agent"); asm volatile("s_waitcnt vmcnt(0)" ::: "memory");
    }
    __syncthreads();
}
constexpr int N_PHASES = 1 + 7 * DEPTH + 1;
__global__ void __launch_bounds__(512, 2) fwd_kernel(Params p) {
    extern __shared__ __attribute__((aligned(16))) unsigned char lds_raw[];
    LAS unsigned char* lds = (LAS unsigned char*)lds_raw;
    cg::grid_group grid = cg::this_grid();
    const bool fused = (p.ph_hi - p.ph_lo) > 1;
    volatile LAS unsigned* st = (volatile LAS unsigned*)(lds + LDS_BYTES);
    XcdBarrier bar; bar.bar = (unsigned*)(p.ws + WS_BAR); bar.x = 0; bar.st = st;
    if (fused) { if (threadIdx.x < 4) st[threadIdx.x] = 0u; __syncthreads(); bar = xcd_barrier_post((unsigned*)(p.ws + WS_BAR), st); }
    int ph = 0;
#define RUN(ph_) ((ph_) >= p.ph_lo && (ph_) < p.ph_hi)
#define SEAM(ph_) do { if ((ph_) + 1 < p.ph_hi) { if (USE_CG || p.ph_hi > 4096) grid.sync(); else xcd_barrier(bar); } } while (0)
#define SEAM_G(ph_) do { if ((ph_) + 1 < p.ph_hi) { if (!USE_CG && gridDim.x == 256) group_barrier(bar.bar, bar.bar + 16u * (blockIdx.x & 7u)); else { SEAM(ph_); } } } while (0)
    bf16_t* XB = (bf16_t*)(p.ws + WS_XN); bf16_t* Pb = (bf16_t*)(p.ws + WS_P); bf16_t* MIX = (bf16_t*)(p.ws + WS_MIX); float* SS = (float*)(p.ws + WS_SS);
    if (RUN(ph)) { if (EN & 1) { prep_tiles(p, lds, 0, 768, (int)blockIdx.x, (int)gridDim.x); prep_gates(p); x_to_bf16(p.x, XB, SS); }   SEAM(ph); } ++ph;
#pragma unroll 1
    for (int l = 0; l < DEPTH; ++l) {
        if (RUN(ph)) { pg8::Gemm g{XB, (const bf16_t*)(p.ws + WS_WIN) + (size_t)l * PN * DM, SEQ, PN, DM}; pg8::StaticOrder S; S.init(SEQ, PN, (int)gridDim.x, (int)blockIdx.x);
            EpiStoreBf16 E{Pb, PN, (LAS float*)(lds + RST_OFF), SS}; if (EN & 32) pg8::gemm_phase<EpiStoreBf16, pg8::StaticOrder, true, true>(lds, g, S, E);
            if (l + 1 < DEPTH) prep_in_tail(p, lds, S, (l + 1) * 768, (l + 1) * 768 + 256); SEAM(ph); } ++ph;
        if (RUN(ph)) { if (EN & 4) { mixer_a(p, l, lds); if (INK_DUP & 4) mixer_a(p, l, lds); } SEAM(ph); } ++ph;
        if (RUN(ph)) { if (EN & 8) scan_phase(p, lds); SEAM(ph); } ++ph;
        if (RUN(ph)) { if (EN & 16) { mixer_b(p, l, lds); if (INK_DUP & 16) mixer_b(p, l, lds); } SEAM(ph); } ++ph;
        if (RUN(ph)) { pg8::Gemm g{MIX, (const bf16_t*)(p.ws + WS_WOUT) + (size_t)l * DM * DM, SEQ, DM, DM}; pg8::StaticOrder S; S.init(SEQ, DM, (int)gridDim.x, (int)blockIdx.x);
            EpiRes E{XB, SS, DM}; if (EN & 64) pg8::gemm_phase<EpiRes, pg8::StaticOrder, false, true>(lds, g, S, E); SEAM_G(ph); } ++ph;
        if (RUN(ph)) { pg8::Gemm g{XB, (const bf16_t*)(p.ws + WS_WF1) + (size_t)l * 2 * DFF * DM, SEQ, 2 * DFF, DM}; pg8::StaticOrder S; S.init(SEQ, 2 * DFF, (int)gridDim.x, (int)blockIdx.x);
            EpiSwiglu E{Pb, DFF, (LAS float*)(lds + RST_OFF), SS}; if (EN & 128) pg8::gemm_phase<EpiSwiglu, pg8::StaticOrder, true, true>(lds, g, S, E);
            if (l + 1 < DEPTH) prep_in_tail(p, lds, S, (l + 1) * 768 + 256, (l + 2) * 768); SEAM_G(ph); } ++ph;
        if (RUN(ph)) { pg8::Gemm g{Pb, (const bf16_t*)(p.ws + WS_WF2) + (size_t)l * DM * DFF, SEQ, DM, DFF}; pg8::StaticOrder S; S.init(SEQ, DM, (int)gridDim.x, (int)blockIdx.x);
            EpiRes E{XB, SS, DM}; if (EN & 256) pg8::gemm_phase<EpiRes, pg8::StaticOrder, false, true>(lds, g, S, E); SEAM_G(ph); } ++ph;
    }
    if (RUN(ph)) { final_norm(XB, p.out, SS, p.final_norm); } ++ph;
}

extern "C" void kernel_launch(void* const* d_in, const int* in_sizes, int n_in, void* d_out, int out_size, void* d_ws, size_t ws_size, hipStream_t stream) {
    static int grid = 0;
    if (grid == 0) {
        if (n_in != 18 || in_sizes[0] != SEQ * DM || out_size != SEQ * DM || ws_size < WS_END) { fprintf(stderr, "kernel_launch: unexpected shapes / workspace (n_in %d, ws %zu < %zu)\n", n_in, ws_size, (size_t)WS_END); grid = -1; return; }
        int dev = 0, cus = 0, per_cu = 0;
        hipGetDevice(&dev); hipDeviceGetAttribute(&cus, hipDeviceAttributeMultiprocessorCount, dev);
        if (hipFuncSetAttribute((const void*)fwd_kernel, hipFuncAttributeMaxDynamicSharedMemorySize, LDS_TOTAL) != hipSuccess) { fprintf(stderr, "kernel_launch: hipFuncSetAttribute failed\n"); grid = -1; return; }
        if (hipOccupancyMaxActiveBlocksPerMultiprocessor(&per_cu, (const void*)fwd_kernel, 512, LDS_TOTAL) != hipSuccess || per_cu < 1) { fprintf(stderr, "kernel_launch: occupancy query says %d blocks per CU\n", per_cu); (void)hipGetLastError(); per_cu = 1; }
        grid = cus * 1;
        fprintf(stderr, "kernel_launch: grid %d (cus %d, per_cu %d)\n", grid, cus, per_cu);
    }
    if (grid < 0) return;
    Params p{};
    p.x = (const float*)d_in[0]; p.norm1 = (const float*)d_in[1]; p.w_in = (const float*)d_in[2]; p.conv_w = (const float*)d_in[3]; p.conv_b = (const float*)d_in[4];
    p.lru_wa = (const float*)d_in[5]; p.lru_ba = (const float*)d_in[6]; p.lru_wi = (const float*)d_in[7]; p.lru_bi = (const float*)d_in[8]; p.lru_lambda = (const float*)d_in[9];
    p.gla_w_alpha = (const float*)d_in[10]; p.gla_b_alpha = (const float*)d_in[11]; p.gla_norm = (const float*)d_in[12]; p.w_out = (const float*)d_in[13]; p.norm2 = (const float*)d_in[14];
    p.w_ffn_in = (const float*)d_in[15]; p.w_ffn_out = (const float*)d_in[16]; p.final_norm = (const float*)d_in[17];
    p.out = (float*)d_out; p.ws = (unsigned char*)d_ws;
#if SINGLE_LAUNCH
    p.ph_lo = 0; p.ph_hi = N_PHASES;
    (void)hipMemsetAsync((unsigned char*)d_ws + WS_BAR, 0, (size_t)XCD_BAR_WORDS * 4, stream);
    void* args[] = {&p};
    hipError_t e = hipLaunchCooperativeKernel((const void*)fwd_kernel, dim3(grid), dim3(512), args, LDS_TOTAL, stream);
    if (e != hipSuccess) fprintf(stderr, "cooperative launch failed: %s (grid %d)\n", hipGetErrorString(e), grid);
#else
    for (int i = 0; i < N_PHASES; ++i) { p.ph_lo = i; p.ph_hi = i + 1; const int kind = (i == 0) ? 0 : (i == N_PHASES - 1) ? 10 : 1 + (i - 1) % 7;
        const int reps = ((DUP_MASK >> kind) & 1) ? 2 : 1;
        for (int r = 0; r < reps; ++r) hipLaunchKernelGGL(fwd_kernel, dim3(grid), dim3(512), LDS_TOTAL, stream, p); }
#endif
}
```
